# Optimizing an MI355X kernel written in HIP

```python
import jax, jax.numpy as jnp
from jax import lax
import numpy as np

D_MODEL = 1024
BATCH = 8
SEQ = 2048
DEPTH = 1
DEC_BATCH = 128
DEC_SEQ = 1
PAST_LEN = 16384
PAGE_SIZE = 128

N_META = 16
CHUNK = 128
ML_HEADS = 4
ML_DK = D_MODEL // ML_HEADS
ML_DV = D_MODEL // ML_HEADS
RT_HEADS = 4
RT_DK = D_MODEL // RT_HEADS
RT_DV = D_MODEL // RT_HEADS
ML_W = ML_HEADS * ML_DV
RT_W = RT_HEADS * RT_DV
D_FF = ((-(-8 * D_MODEL // 3) + 255) // 256) * 256
ROPE_BASE = 10000.0
ALPHA = (2 * DEPTH) ** 0.25
BETA = (8 * DEPTH) ** -0.25
LN_EPS = 1e-5
SPLIT_SIZES = (ML_HEADS * ML_DK, ML_HEADS * ML_DK, ML_W, ML_W, ML_HEADS, ML_HEADS,
               RT_HEADS * RT_DK, RT_HEADS * RT_DK, RT_W, RT_W, D_MODEL, D_MODEL)
D_IN = sum(SPLIT_SIZES)

kernel_name = "mlstm_retention_gated_hybrid_step"


def _starts():
    return [int(s) for s in np.cumsum((0,) + SPLIT_SIZES)]


def layer_norm(x, g, b):
    xf = x.astype(jnp.float32)
    mu = jnp.mean(xf, axis=-1, keepdims=True)
    var = jnp.mean(jnp.square(xf - mu), axis=-1, keepdims=True)
    return ((xf - mu) * lax.rsqrt(var + LN_EPS) * g.astype(jnp.float32) + b.astype(jnp.float32)).astype(x.dtype)


def to_heads(t, n_heads):
    b_, l_, _ = t.shape
    return t.reshape(b_, l_, n_heads, -1).transpose(0, 2, 1, 3)


def head_norm_merge(h, g):
    n_heads, d = h.shape[1], h.shape[3]
    mu = jnp.mean(h, axis=-1, keepdims=True)
    var = jnp.mean(jnp.square(h - mu), axis=-1, keepdims=True)
    h = (h - mu) * lax.rsqrt(var + LN_EPS) * g.astype(jnp.float32).reshape(n_heads, 1, d)
    b_, _, l_, _ = h.shape
    return h.transpose(0, 2, 1, 3).reshape(b_, l_, n_heads * d)


def rotary(t, pos):
    d = t.shape[-1]
    inv = ROPE_BASE ** (-jnp.arange(0, d, 2, dtype=jnp.float32) / d)
    ang = pos[:, None] * inv[None, :]
    cos, sin = jnp.cos(ang), jnp.sin(ang)
    t1, t2 = t[..., : d // 2], t[..., d // 2:]
    return jnp.concatenate([t1 * cos - t2 * sin, t1 * sin + t2 * cos], axis=-1)


def mlstm_step(carry, xs):
    C, n, m = carry
    q, k, v, logi, logf = xs
    L = q.shape[2]
    b = jnp.cumsum(logf, axis=-1)
    causal = jnp.tril(jnp.ones((L, L), dtype=bool))
    dmat = jnp.where(causal, b[..., :, None] - b[..., None, :] + logi[..., None, :], -jnp.inf)
    inter = b + m[..., None]
    m_t = jnp.maximum(inter, jnp.max(dmat, axis=-1))
    w_intra = jnp.exp(dmat - m_t[..., None])
    w_inter = jnp.exp(inter - m_t)
    s = jnp.einsum('bhtd,bhsd->bhts', q, k) * w_intra
    num = (w_inter[..., None] * jnp.einsum('bhtd,bhde->bhte', q, C)
           + jnp.einsum('bhts,bhse->bhte', s, v))
    den = w_inter * jnp.einsum('bhtd,bhd->bht', q, n) + jnp.sum(s, axis=-1)
    h = num / jnp.maximum(jnp.abs(den), jnp.exp(-m_t))[..., None]
    b_last = b[..., -1]
    g_s = b_last[..., None] - b + logi
    m_new = jnp.maximum(b_last + m, jnp.max(g_s, axis=-1))
    w_s = jnp.exp(g_s - m_new[..., None])
    w_c = jnp.exp(b_last + m - m_new)
    C_new = w_c[..., None, None] * C + jnp.einsum('bhs,bhsd,bhse->bhde', w_s, k, v)
    n_new = w_c[..., None] * n + jnp.einsum('bhs,bhsd->bhd', w_s, k)
    return (C_new, n_new, m_new), h


def retention_step(S, xs):
    q, k, v = xs
    L = q.shape[2]
    lg = jnp.log1p(-jnp.exp2(-5.0 - jnp.arange(RT_HEADS, dtype=jnp.float32)))
    t = jnp.arange(L, dtype=jnp.float32)
    causal = t[:, None] >= t[None, :]
    decay = jnp.where(causal[None], jnp.exp((t[:, None] - t[None, :])[None] * lg[:, None, None]), 0.0)
    scores = jnp.einsum('bhtd,bhsd->bhts', q, k) * decay[None]
    o = (jnp.einsum('bhts,bhse->bhte', scores, v)
         + jnp.exp((t + 1.0)[None, :] * lg[:, None])[None, :, :, None] * jnp.einsum('bhtd,bhde->bhte', q, S))
    w = jnp.exp((L - 1.0 - t)[None, :] * lg[:, None])
    S_new = jnp.exp(L * lg)[None, :, None, None] * S + jnp.einsum('hs,bhsd,bhse->bhde', w, k, v)
    return S_new, o


def run_prompt(step, carry, xs):
    lead = jax.tree_util.tree_map(lambda a: a[:, :, :N_META], xs)
    carry, h_lead = step(carry, lead)

    def to_chunks(a):
        b_, h_, l_ = a.shape[:3]
        a = a[:, :, N_META:].reshape(b_, h_, (l_ - N_META) // CHUNK, CHUNK, *a.shape[3:])
        return jnp.moveaxis(a, 2, 0)

    carry, h_rest = lax.scan(step, carry, jax.tree_util.tree_map(to_chunks, xs))
    h_rest = jnp.moveaxis(h_rest, 0, 2)
    h_rest = h_rest.reshape(h_rest.shape[0], h_rest.shape[1], -1, h_rest.shape[-1])
    return carry, jnp.concatenate([h_lead, h_rest], axis=2)


def run_single(step, carry, xs):
    return step(carry, xs)


def token_mix(x, pos, run, ml_state, rt_state, w_in, b_in, ml_norm_g, rt_norm_g, w_out):
    f32 = jnp.float32
    proj = x @ w_in + b_in
    st = _starts()
    (mq, mk, mv, mo, mi, mf, rq, rk, rv, rg, ga, gb) = jnp.split(proj, st[1:-1], axis=-1)
    q = to_heads(mq, ML_HEADS).astype(f32)
    k = to_heads(mk, ML_HEADS).astype(f32) * (ML_DK ** -0.5)
    v = to_heads(mv, ML_HEADS).astype(f32)
    logi = mi.astype(f32).transpose(0, 2, 1)
    logf = jax.nn.log_sigmoid(mf.astype(f32)).transpose(0, 2, 1)
    ml_state, h_a = run(mlstm_step, ml_state, (q, k, v, logi, logf))
    h_a = head_norm_merge(h_a, ml_norm_g) * jax.nn.sigmoid(mo.astype(f32))
    rq_h = rotary(to_heads(rq, RT_HEADS).astype(f32), pos)
    rk_h = rotary(to_heads(rk, RT_HEADS).astype(f32), pos) * (RT_DK ** -0.5)
    rv_h = to_heads(rv, RT_HEADS).astype(f32)
    rt_state, h_b = run(retention_step, rt_state, (rq_h, rk_h, rv_h))
    h_b = head_norm_merge(h_b, rt_norm_g) * jax.nn.silu(rg.astype(f32))
    merged = jax.nn.sigmoid(ga.astype(f32)) * h_a + jax.nn.sigmoid(gb.astype(f32)) * h_b
    return merged.astype(x.dtype) @ w_out, ml_state, rt_state


def swiglu(x, w_gate, w_up, w_down):
    return (jax.nn.silu(x @ w_gate) * (x @ w_up)) @ w_down


def trunk(x, pos, run, ml_states, rt_states, w_in, b_in, ml_norm_g, rt_norm_g, w_out,
          ln1_g, ln1_b, w_gate, w_up, w_down, ln2_g, ln2_b):
    out_ml, out_rt = [], []
    for l in range(DEPTH):
        mix, ml_s, rt_s = token_mix(x, pos, run, ml_states[l], rt_states[l], w_in[l], b_in[l],
                                    ml_norm_g[l], rt_norm_g[l], w_out[l])
        x = layer_norm(ALPHA * x + mix, ln1_g[l], ln1_b[l])
        x = layer_norm(ALPHA * x + swiglu(x, w_gate[l], w_up[l], w_down[l]), ln2_g[l], ln2_b[l])
        out_ml.append(ml_s)
        out_rt.append(rt_s)
    C = jnp.stack([s[0] for s in out_ml])
    n = jnp.stack([s[1] for s in out_ml])
    m = jnp.stack([s[2] for s in out_ml])
    S = jnp.stack(out_rt)
    return x, C, n, m, S


def setup_inputs(seed: int = 0) -> dict:
    key = jax.random.key(seed)
    ks = jax.random.split(key, 24)
    f32 = jnp.float32
    st = _starts()
    col_scale = jnp.ones((D_IN,), f32)
    col_scale = col_scale.at[st[2]:st[3]].set(BETA).at[st[8]:st[9]].set(BETA)
    w_in = jax.random.normal(ks[0], (DEPTH, D_MODEL, D_IN), f32) * (D_MODEL ** -0.5) * col_scale
    b_in = jax.random.normal(ks[1], (DEPTH, D_IN), f32) * 0.02
    f_bias = jnp.linspace(3.0, 6.0, ML_HEADS, dtype=f32) + 0.1 * jax.random.normal(ks[2], (DEPTH, ML_HEADS), f32)
    b_in = b_in.at[:, st[5]:st[6]].set(f_bias)
    return {
        "x_prompt": jax.random.normal(ks[3], (BATCH, SEQ, D_MODEL), f32),
        "x_sample": jax.random.normal(ks[4], (DEC_BATCH, DEC_SEQ, D_MODEL), f32),
        "state_mlstm_C": jax.random.normal(ks[5], (DEPTH, DEC_BATCH, ML_HEADS, ML_DK, ML_DV), f32) * 0.1,
        "state_mlstm_n": jax.random.normal(ks[6], (DEPTH, DEC_BATCH, ML_HEADS, ML_DK), f32) * 0.1,
        "state_mlstm_m": jax.random.normal(ks[7], (DEPTH, DEC_BATCH, ML_HEADS), f32),
        "state_ret_S": jax.random.normal(ks[8], (DEPTH, DEC_BATCH, RT_HEADS, RT_DK, RT_DV), f32) * 0.1,
        "meta_tokens": jax.random.normal(ks[9], (N_META, D_MODEL), f32),
        "w_in": w_in,
        "b_in": b_in,
        "ml_norm_g": 1.0 + 0.02 * jax.random.normal(ks[10], (DEPTH, ML_W), f32),
        "rt_norm_g": 1.0 + 0.02 * jax.random.normal(ks[11], (DEPTH, RT_W), f32),
        "w_out": jax.random.normal(ks[12], (DEPTH, D_MODEL, D_MODEL), f32) * (D_MODEL ** -0.5) * BETA,
        "ln1_g": 1.0 + 0.02 * jax.random.normal(ks[13], (DEPTH, D_MODEL), f32),
        "ln1_b": 0.02 * jax.random.normal(ks[14], (DEPTH, D_MODEL), f32),
        "w_gate": jax.random.normal(ks[15], (DEPTH, D_MODEL, D_FF), f32) * (D_MODEL ** -0.5) * BETA,
        "w_up": jax.random.normal(ks[16], (DEPTH, D_MODEL, D_FF), f32) * (D_MODEL ** -0.5) * BETA,
        "w_down": jax.random.normal(ks[17], (DEPTH, D_FF, D_MODEL), f32) * (D_FF ** -0.5) * BETA,
        "ln2_g": 1.0 + 0.02 * jax.random.normal(ks[18], (DEPTH, D_MODEL), f32),
        "ln2_b": 0.02 * jax.random.normal(ks[19], (DEPTH, D_MODEL), f32),
    }


def reference(x_prompt, x_sample, state_mlstm_C, state_mlstm_n, state_mlstm_m, state_ret_S,
              meta_tokens, w_in, b_in, ml_norm_g, rt_norm_g, w_out,
              ln1_g, ln1_b, w_gate, w_up, w_down, ln2_g, ln2_b):
    f32 = jnp.float32
    meta = jnp.broadcast_to(meta_tokens.astype(x_prompt.dtype)[None], (BATCH, N_META, D_MODEL))
    xp = jnp.concatenate([meta, x_prompt], axis=1)
    pos_p = jnp.arange(N_META + SEQ, dtype=f32)
    ml0 = [(jnp.zeros((BATCH, ML_HEADS, ML_DK, ML_DV), f32), jnp.zeros((BATCH, ML_HEADS, ML_DK), f32),
            jnp.zeros((BATCH, ML_HEADS), f32)) for _ in range(DEPTH)]
    rt0 = [jnp.zeros((BATCH, RT_HEADS, RT_DK, RT_DV), f32) for _ in range(DEPTH)]
    yp, p_C, p_n, p_m, p_S = trunk(xp, pos_p, run_prompt, ml0, rt0, w_in, b_in, ml_norm_g, rt_norm_g, w_out,
                                   ln1_g, ln1_b, w_gate, w_up, w_down, ln2_g, ln2_b)
    y_prompt = yp[:, N_META:]
    pos_s = PAST_LEN + jnp.arange(DEC_SEQ, dtype=f32)
    mls = [(state_mlstm_C[l].astype(f32), state_mlstm_n[l].astype(f32), state_mlstm_m[l].astype(f32))
           for l in range(DEPTH)]
    rts = [state_ret_S[l].astype(f32) for l in range(DEPTH)]
    y_sample, s_C, s_n, s_m, s_S = trunk(x_sample, pos_s, run_single, mls, rts, w_in, b_in, ml_norm_g, rt_norm_g,
                                         w_out, ln1_g, ln1_b, w_gate, w_up, w_down, ln2_g, ln2_b)
    return (y_prompt, y_sample, p_C, p_n, p_m, p_S, s_C, s_n, s_m, s_S)
```

```cpp
#include <hip/hip_runtime.h>
#include <hip/hip_cooperative_groups.h>
#include <cstdio>
#include <cstdint>
namespace cg = cooperative_groups;
namespace pg8 {
#define PG8_LAS __attribute__((address_space(3)))
typedef unsigned short bf16_t;
typedef short bf16x8 __attribute__((ext_vector_type(8)));
typedef float f32x4 __attribute__((ext_vector_type(4)));
typedef unsigned u32x4 __attribute__((ext_vector_type(4)));
constexpr int BM = 256, BK = 64, HALF = 128, HTB = HALF * BK * 2  , STAGE_BYTES = 8 * HTB, NXCD = 8, WGM = 8;

__host__ __device__ __forceinline__ int lds_byte(int r, int c) { const int st = (r >> 4) * 2 + (c >> 5), rr = r & 15, cc = c & 31, ob = rr * 64 + cc * 2; return st * 1024 + (ob ^ (((ob >> 9) & 1) << 5)); }
__host__ __device__ __forceinline__ void stage_rc(int b, int& R, int& C) { const int st = b / 1024, sb = b % 1024, swz = sb ^ (((sb >> 9) & 1) << 5); R = (st >> 1) * 16 + swz / 64; C = (st & 1) * 32 + (swz % 64) / 2; }
__host__ __device__ __forceinline__ int perm32(int rho) { const int n = rho >> 4, i = rho & 15; return 8 * (i >> 2) + 4 * n + (i & 3); }

struct Unit { int pm, pn; };
struct Gemm { const bf16_t* A; const bf16_t* Bt; int M, N, K; int ld; size_t a_pm, b_pm, b_pn; };

struct StaticOrder {
    int nM, nN, nwg, G, c;
    __host__ __device__ void init(int M, int N, int G_, int c_) { nM = M / BM; nN = N / BM; nwg = nM * nN; G = G_; c = c_; }
    __host__ __device__ bool next(int i, Unit& u) const {
        const long L = (long)i * G + c; if (L >= nwg) return false;
        int wgid = (int)L; { const int q = nwg / NXCD, r = nwg % NXCD, xcd = wgid % NXCD, off = wgid / NXCD; wgid = (xcd < r ? xcd * (q + 1) : r * (q + 1) + (xcd - r) * q) + off; }
        const int nig = WGM * nN, gid = wgid / nig, fm = gid * WGM, gsz = (nM - fm) < WGM ? (nM - fm) : WGM;
        u.pm = fm + ((wgid % nig) % gsz); u.pn = (wgid % nig) / gsz; return true;
    }
    __device__ __forceinline__ void a_ready(const Unit&) const {}
    __device__ __forceinline__ void done(const Unit&) const {}
};

__device__ __forceinline__ unsigned cvt_pk_bf16(float lo, float hi) { unsigned r; asm volatile("v_cvt_pk_bf16_f32 %0, %1, %2" : "=v"(r) : "v"(lo), "v"(hi)); return r; }
template <class Epi, class Sched, bool ALIGN_EPI = false, bool SP2 = false>
__device__ __forceinline__ void gemm_phase(PG8_LAS unsigned char* lds, const Gemm g, const Sched& S, const Epi& E) {
    const int tid = threadIdx.x, wid = __builtin_amdgcn_readfirstlane(tid >> 6), lane = tid & 63, wr = wid >> 2, wc = wid & 3, fr = lane & 15, fq = lane >> 4;
    const int K = g.K, nt = K / BK;
    unsigned voffA[2], voffB[2];
#pragma unroll
    for (int i = 0; i < 2; ++i) { int R, C; stage_rc(tid * 16 + i * 8192, R, C); const int Rb = Epi::PERM ? ((R & ~31) + perm32(R & 31)) : R;
        voffA[i] = (unsigned)(R * g.ld + C) * 2u; voffB[i] = (unsigned)(Rb * g.ld + C) * 2u; }
    const size_t kstep = (size_t)(BK * 2);
    const size_t hstep = (size_t)HALF * g.ld * 2;
    const size_t tstep = 2 * hstep;
    const unsigned ldsw = (unsigned)wid * 1024u;
    const int aoff = lds_byte(wr * 64 + fr, fq * 8), boff = lds_byte(wc * 32 + fr, fq * 8);
#define PG8_SA(b, h) (((b) * 2 + (h)) * HTB)
#define PG8_SB(b, h) ((4 + (b) * 2 + (h)) * HTB)
#define PG8_STAGE(bufoff, gbase, voff) do { _Pragma("unroll") for (int _i = 0; _i < 2; ++_i) \
        __builtin_amdgcn_global_load_lds((const unsigned*)((const char*)(gbase) + (voff)[_i]), (PG8_LAS unsigned*)(lds + (bufoff) + ldsw + _i * 8192), 16, 0, 0); } while (0)
#define PG8_LDA(dst, b, h) do { _Pragma("unroll") for (int m = 0; m < 4; ++m) _Pragma("unroll") for (int k = 0; k < 2; ++k) dst[m][k] = *(const PG8_LAS bf16x8*)(lds + PG8_SA(b, h) + aoff + m * 2048 + k * 1024); } while (0)
#define PG8_LDB(dst, b, h) do { _Pragma("unroll") for (int n = 0; n < 2; ++n) _Pragma("unroll") for (int k = 0; k < 2; ++k) dst[n][k] = *(const PG8_LAS bf16x8*)(lds + PG8_SB(b, h) + boff + n * 2048 + k * 1024); } while (0)
#define PG8_MMA(ai, bj, At, Bt) do { __builtin_amdgcn_s_setprio(1); _Pragma("unroll") for (int m = 0; m < 4; ++m) _Pragma("unroll") for (int n = 0; n < 2; ++n) _Pragma("unroll") for (int k = 0; k < 2; ++k) \
        acc[ai][bj][m][n] = __builtin_amdgcn_mfma_f32_16x16x32_bf16(Bt[n][k], At[m][k], acc[ai][bj][m][n], 0, 0, 0); __builtin_amdgcn_s_setprio(0); } while (0)
#define PG8_WAIT_V(n) asm volatile("s_waitcnt vmcnt(" #n ")" ::: "memory")
#define PG8_WAIT_L(n) asm volatile("s_waitcnt lgkmcnt(" #n ")" ::: "memory")
#define PG8_BAR __builtin_amdgcn_s_barrier()
#define PG8_SCHED __builtin_amdgcn_sched_barrier(0)
    Unit cur, nxt; int ui = 0;
    if (!S.next(0, cur)) return;
    f32x4 acc[2][2][4][2];
#pragma unroll
    for (int a = 0; a < 2; ++a)
#pragma unroll
        for (int b = 0; b < 2; ++b)
#pragma unroll
            for (int m = 0; m < 4; ++m)
#pragma unroll
                for (int n = 0; n < 2; ++n) acc[a][b][m][n] = (f32x4){0.f, 0.f, 0.f, 0.f};
    bf16x8 At[4][2], B0[2][2], B1[2][2];
    const char* cA = (const char*)g.A + (size_t)cur.pm * g.a_pm; const char* cB = (const char*)g.Bt + (size_t)cur.pm * g.b_pm + (size_t)cur.pn * g.b_pn;
    S.a_ready(cur);
    if constexpr (SP2) {
        PG8_STAGE(PG8_SB(0, 0), cB, voffB); PG8_STAGE(PG8_SB(0, 1), cB + hstep, voffB); PG8_STAGE(PG8_SA(0, 0), cA, voffA); PG8_STAGE(PG8_SA(0, 1), cA + hstep, voffA);
        if (wr == 1) PG8_BAR;
        PG8_WAIT_V(2); PG8_BAR;
        PG8_STAGE(PG8_SB(1, 0), cB + kstep, voffB); PG8_STAGE(PG8_SA(1, 0), cA + kstep, voffA); PG8_STAGE(PG8_SB(1, 1), cB + hstep + kstep, voffB);
        PG8_WAIT_V(6); PG8_BAR;
    } else {
        PG8_STAGE(PG8_SB(0, 0), cB, voffB); PG8_STAGE(PG8_SA(0, 0), cA, voffA); PG8_STAGE(PG8_SB(0, 1), cB + hstep, voffB); PG8_STAGE(PG8_SA(0, 1), cA + hstep, voffA);
        if (wr == 1) PG8_BAR;
        PG8_WAIT_V(4); PG8_BAR;
        PG8_STAGE(PG8_SB(1, 0), cB + kstep, voffB); PG8_STAGE(PG8_SA(1, 0), cA + kstep, voffA); PG8_STAGE(PG8_SB(1, 1), cB + hstep + kstep, voffB);
        PG8_WAIT_V(6); PG8_BAR;
    }
    for (;;) {
        const bool has_next = S.next(ui + 1, nxt);
        const char* nA = has_next ? (const char*)g.A + (size_t)nxt.pm * g.a_pm : cA; const char* nB = has_next ? (const char*)g.Bt + (size_t)nxt.pm * g.b_pm + (size_t)nxt.pn * g.b_pn : cB;
        for (int t = 0; t < nt; t += 2) {
            const bool last = (t == nt - 2);
            const char* a1 = cA + (size_t)(t + 1) * kstep;
            const char* a2 = last ? nA : cA + (size_t)(t + 2) * kstep; const char* b2 = last ? nB : cB + (size_t)(t + 2) * kstep;
            const char* a3 = a2 + kstep; const char* b3 = b2 + kstep;
            if (last && has_next) S.a_ready(nxt);
            if constexpr (SP2) {
            PG8_LDB(B0, 0, 0); PG8_LDB(B1, 0, 1); PG8_SCHED; PG8_LDA(At, 0, 0); PG8_STAGE(PG8_SA(1, 1), a1 + hstep, voffA);
            PG8_WAIT_V(8); PG8_WAIT_L(0); PG8_BAR; PG8_MMA(0, 0, At, B0); PG8_MMA(0, 1, At, B1); PG8_BAR; PG8_SCHED;
            PG8_LDA(At, 0, 1); PG8_STAGE(PG8_SB(0, 0), b2, voffB); PG8_STAGE(PG8_SB(0, 1), b2 + hstep, voffB); PG8_STAGE(PG8_SA(0, 0), a2, voffA);
            PG8_WAIT_V(8); PG8_WAIT_L(0); PG8_BAR; PG8_MMA(1, 0, At, B0); PG8_MMA(1, 1, At, B1); PG8_BAR; PG8_SCHED;
            PG8_LDB(B0, 1, 0); PG8_LDB(B1, 1, 1); PG8_SCHED; PG8_LDA(At, 1, 0); PG8_STAGE(PG8_SA(0, 1), a2 + hstep, voffA);
            PG8_WAIT_V(8); PG8_WAIT_L(0); PG8_BAR; PG8_MMA(0, 0, At, B0); PG8_MMA(0, 1, At, B1); PG8_BAR; PG8_SCHED;
            PG8_LDA(At, 1, 1); PG8_STAGE(PG8_SB(1, 0), b3, voffB); PG8_STAGE(PG8_SB(1, 1), b3 + hstep, voffB); PG8_STAGE(PG8_SA(1, 0), a3, voffA);
            PG8_WAIT_V(8); PG8_WAIT_L(0); PG8_BAR; PG8_MMA(1, 0, At, B0); PG8_MMA(1, 1, At, B1); PG8_BAR; PG8_SCHED;
            } else {
            PG8_LDB(B0, 0, 0); PG8_SCHED; PG8_LDA(At, 0, 0); PG8_STAGE(PG8_SA(1, 1), a1 + hstep, voffA);
            PG8_WAIT_L(8); PG8_BAR; PG8_WAIT_L(0); PG8_MMA(0, 0, At, B0); PG8_BAR; PG8_SCHED;
            PG8_LDB(B1, 0, 1); PG8_STAGE(PG8_SB(0, 0), b2, voffB);
            PG8_BAR; PG8_WAIT_L(0); PG8_MMA(0, 1, At, B1); PG8_BAR;
            PG8_LDA(At, 0, 1); PG8_STAGE(PG8_SA(0, 0), a2, voffA);
            PG8_BAR; PG8_WAIT_L(0); PG8_MMA(1, 0, At, B0); PG8_BAR; PG8_SCHED;
            PG8_STAGE(PG8_SB(0, 1), b2 + hstep, voffB);
            PG8_WAIT_V(6); PG8_BAR; PG8_MMA(1, 1, At, B1); PG8_BAR;
            PG8_LDB(B0, 1, 0); PG8_SCHED; PG8_LDA(At, 1, 0); PG8_STAGE(PG8_SA(0, 1), a2 + hstep, voffA);
            PG8_WAIT_L(8); PG8_BAR; PG8_WAIT_L(0); PG8_MMA(0, 0, At, B0); PG8_BAR; PG8_SCHED;
            PG8_LDB(B1, 1, 1); PG8_STAGE(PG8_SB(1, 0), b3, voffB);
            PG8_BAR; PG8_WAIT_L(0); PG8_MMA(0, 1, At, B1); PG8_BAR;
            PG8_LDA(At, 1, 1); PG8_STAGE(PG8_SA(1, 0), a3, voffA);
            PG8_BAR; PG8_WAIT_L(0); PG8_MMA(1, 0, At, B0); PG8_BAR; PG8_SCHED;
            PG8_STAGE(PG8_SB(1, 1), b3 + hstep, voffB);
            PG8_WAIT_V(6); PG8_BAR; PG8_MMA(1, 1, At, B1); PG8_BAR;
            }
        }
        if constexpr (ALIGN_EPI) { if (wr == 0) PG8_BAR; }
        if constexpr (!Epi::AFTER_DRAIN) { E(acc, cur, wr, wc, fr, fq); S.done(cur); }
        if (!has_next) break;
#pragma unroll
        for (int a = 0; a < 2; ++a)
#pragma unroll
            for (int b = 0; b < 2; ++b)
#pragma unroll
                for (int m = 0; m < 4; ++m)
#pragma unroll
                    for (int n = 0; n < 2; ++n) acc[a][b][m][n] = (f32x4){0.f, 0.f, 0.f, 0.f};
        cur = nxt; cA = nA; cB = nB; ++ui;
        if constexpr (ALIGN_EPI) { if (wr == 1) PG8_BAR; }
    }
    PG8_WAIT_V(0);
    if constexpr (!ALIGN_EPI) { if (wr == 0) PG8_BAR; }
    PG8_BAR;
    if constexpr (Epi::AFTER_DRAIN) { E.fused(acc, cur, wr, wc, fr, fq, lds, wid, lane); S.done(cur); }
#undef PG8_SA
#undef PG8_SB
#undef PG8_STAGE
#undef PG8_LDA
#undef PG8_LDB
#undef PG8_MMA
#undef PG8_WAIT_V
#undef PG8_WAIT_L
#undef PG8_BAR
#undef PG8_SCHED
}
}

#define LAS __attribute__((address_space(3)))
typedef unsigned short bf16;
typedef float f32x4 __attribute__((ext_vector_type(4)));
typedef short bf16x8 __attribute__((ext_vector_type(8)));
typedef unsigned u32x4 __attribute__((ext_vector_type(4)));
typedef unsigned u32x2 __attribute__((ext_vector_type(2)));

constexpr int NTHR = 512;
constexpr int DM = 1024, NB = 8, SEQ = 2048, NMETA = 16, DEC = 128, NH = 4, HD = 256, DFF = 2816, NCOL_SRC = 10248;
constexpr int MROWS = 16640;
constexpr int ROW_S = 16384, ROW_M = 16512, ROW_V = 16512  ;
constexpr int NPOS = 2065;
constexpr int SCN = 2065;
constexpr float LN_EPS = 1e-5f;
constexpr float ALPHA = 1.189207115002721f;

constexpr size_t MiB = 1u << 20;
constexpr size_t SLOT = (size_t)MROWS * 1024 * 2;
constexpr size_t WS_WIN = 0;
constexpr size_t WS_HA = 0, WS_HB = SLOT;
constexpr size_t WS_XB = 65 * MiB;
constexpr size_t WS_WOUT = WS_XB + SLOT;
constexpr size_t WS_WGU = WS_WOUT + 2 * MiB;
constexpr size_t WS_WDN = WS_WGU + 11 * MiB;
constexpr size_t WS_G = 116 * MiB;
constexpr size_t WS_ROT = 117 * MiB;
constexpr size_t WS_SF = 119 * MiB + 256 * 1024, WS_SM = 119 * MiB + 640 * 1024;
static_assert(WS_ROT + (size_t)NPOS * 128 * 8 <= WS_SF && WS_SF + 32 * SCN * 4 <= WS_SM && WS_SM + 32 * SCN * 4 <= 120 * MiB, "ws map (scan arrays)");
constexpr size_t WS_PROJ = 120 * MiB;
constexpr size_t WS_END = WS_PROJ + 12 * SLOT;
constexpr size_t WS_PRE1 = WS_PROJ, WS_X1 = WS_PROJ + 65 * MiB, WS_X1B = WS_PROJ + 130 * MiB, WS_HBUF = WS_PROJ + 163 * MiB, WS_PRE2 = WS_PROJ + 253 * MiB, WS_PART4 = WS_PROJ + 320 * MiB, WS_PART7 = WS_PROJ + 328 * MiB;
static_assert(WS_WDN + (size_t)DM * DFF * 2 <= WS_G && WS_HBUF + (size_t)MROWS * DFF * 2 <= WS_PRE2 && WS_PRE2 + 65 * MiB <= WS_END, "ws map");

constexpr int LDS_BYTES = 155648;
constexpr int KOFF = 0, COFF = 65536, VOFF = COFF + 40960, VBUF = 20480, AOFF = VOFF + 2 * VBUF, ABUF = 2560;
static_assert(AOFF + 2 * ABUF <= LDS_BYTES, "mixer LDS map");

constexpr size_t O_YP = 0, O_YS = 16777216, O_PC = O_YS + 131072, O_PN = O_PC + 2097152, O_PM = O_PN + 8192, O_PS = O_PM + 32,
                 O_SC = O_PS + 2097152, O_SN = O_SC + 33554432, O_SM = O_SN + 131072, O_SS = O_SM + 512;

__device__ __forceinline__ unsigned f2bf(float f) { unsigned u = __builtin_bit_cast(unsigned, f); return (u + 0x7fffu + ((u >> 16) & 1u)) >> 16; }
__device__ __forceinline__ unsigned pk2(float lo, float hi) { return f2bf(lo) | (f2bf(hi) << 16); }
__device__ __forceinline__ float bf2f(unsigned h) { return __builtin_bit_cast(float, h << 16); }
__device__ __forceinline__ float wave_sum(float v) {
#pragma unroll
    for (int o = 1; o < 64; o <<= 1) v += __shfl_xor(v, o);
    return v;
}
__device__ __forceinline__ float sigmoidf_(float x) { return 1.f / (1.f + __expf(-x)); }
__device__ __forceinline__ float logsigf_(float x) { return fminf(x, 0.f) - log1pf(expf(-fabsf(x))); }
__device__ __forceinline__ int opaque_tid() { int t = threadIdx.x; asm volatile("" : "+v"(t)); return t; }
__device__ __forceinline__ int posidx(int row) { return row < ROW_S ? (row & 2047) + 16 : (row < ROW_M ? 2064 : (row < ROW_M + 16 ? row - ROW_M : 0)); }

struct Args {
    const float *x_prompt, *x_sample, *st_C, *st_n, *st_m, *st_S, *meta, *w_in, *b_in, *ml_g, *rt_g, *w_out, *ln1_g, *ln1_b, *w_gate, *w_up, *w_down, *ln2_g, *ln2_b;
    float* out; unsigned char* ws; int ph_lo, ph_hi;
};

__device__ __forceinline__ pg8::Gemm mk_gemm(const bf16* A, const bf16* Bt, int M, int N, int K) { return pg8::Gemm{A, Bt, M, N, K, K, (size_t)512 * K, 0, (size_t)512 * K}; }
__device__ __forceinline__ pg8::Gemm mk_gemm_splitk(const bf16* A, const bf16* Bt, int nsplit, int N, int KS, int ld) { return pg8::Gemm{A, Bt, nsplit * 256, N, KS, ld, (size_t)2 * KS, (size_t)2 * KS, (size_t)512 * ld}; }
struct EpiProj {
    static constexpr bool PERM = false, AFTER_DRAIN = false;
    unsigned char* ws; const float* b_in;
    __device__ __forceinline__ void operator()(const f32x4 (&acc)[2][2][4][2], const pg8::Unit& u, int wr, int wc, int fr, int fq) const {
        const int grp = u.pn >> 2, head = u.pn & 3;
        const int rmslot = grp == 0 ? 0 : grp == 1 ? 1 : grp == 3 ? 2 : grp == 4 ? 3 : grp == 5 ? 4 : grp == 7 ? 5 : grp == 8 ? 6 : grp == 9 ? 7 : -1;
        const int tslot = grp == 1 ? 8 : grp == 2 ? 9 : grp == 5 ? 10 : grp == 6 ? 11 : -1;
        const bool rot = (grp == 4 || grp == 5);
        const int act = (grp == 3 || grp >= 8) ? 1 : (grp == 7 ? 2 : 0);
        const float bsc = (grp == 1 || grp == 5) ? 0.0625f : 1.f;
        const int colh = wc * 32 + 4 * fq;
        const float* bsrc = b_in + grp * 1024 + head * 256 + (grp >= 4 ? 8 : 0) + colh;
        f32x4 bv[2][2];
#pragma unroll
        for (int bj = 0; bj < 2; ++bj)
#pragma unroll
            for (int n = 0; n < 2; ++n) bv[bj][n] = *(const f32x4*)(bsrc + bj * 128 + n * 16) * bsc;
        bf16* rm = rmslot >= 0 ? (bf16*)(ws + WS_PROJ + (size_t)rmslot * SLOT) : nullptr;
        bf16* tb = tslot >= 0 ? (bf16*)(ws + WS_PROJ + (size_t)tslot * SLOT) : nullptr;
        const float* rotp = (const float*)(ws + WS_ROT);
#pragma unroll
        for (int ai = 0; ai < 2; ++ai)
#pragma unroll
            for (int m = 0; m < 4; ++m) {
                const int row = u.pm * 256 + ai * 128 + wr * 64 + m * 16 + fr;
                f32x4 v[2][2];
#pragma unroll
                for (int bj = 0; bj < 2; ++bj)
#pragma unroll
                    for (int n = 0; n < 2; ++n) v[bj][n] = acc[ai][bj][m][n] + bv[bj][n];
                if (rot) {
                    const float* cs = rotp + ((size_t)posidx(row) * 128 + colh) * 2;
#pragma unroll
                    for (int n = 0; n < 2; ++n) {
                        const f32x4 c0 = *(const f32x4*)(cs + n * 32), c1 = *(const f32x4*)(cs + n * 32 + 4);
                        const f32x4 x1 = v[0][n], x2 = v[1][n];
                        v[0][n] = (f32x4){x1[0] * c0[0] - x2[0] * c0[1], x1[1] * c0[2] - x2[1] * c0[3], x1[2] * c1[0] - x2[2] * c1[1], x1[3] * c1[2] - x2[3] * c1[3]};
                        v[1][n] = (f32x4){x1[0] * c0[1] + x2[0] * c0[0], x1[1] * c0[3] + x2[1] * c0[2], x1[2] * c1[1] + x2[2] * c1[0], x1[3] * c1[3] + x2[3] * c1[2]};
                    }
                }
                if (act == 1) {
#pragma unroll
                    for (int bj = 0; bj < 2; ++bj)
#pragma unroll
                        for (int n = 0; n < 2; ++n)
#pragma unroll
                            for (int i = 0; i < 4; ++i) v[bj][n][i] = sigmoidf_(v[bj][n][i]);
                } else if (act == 2) {
#pragma unroll
                    for (int bj = 0; bj < 2; ++bj)
#pragma unroll
                        for (int n = 0; n < 2; ++n)
#pragma unroll
                            for (int i = 0; i < 4; ++i) v[bj][n][i] = v[bj][n][i] * sigmoidf_(v[bj][n][i]);
                }
                if (rm) {
                    bf16* rp = rm + (size_t)row * 1024 + head * 256 + colh;
#pragma unroll
                    for (int bj = 0; bj < 2; ++bj)
#pragma unroll
                        for (int n = 0; n < 2; ++n) { u32x2 w; w.x = pk2(v[bj][n][0], v[bj][n][1]); w.y = pk2(v[bj][n][2], v[bj][n][3]); *(u32x2*)(rp + bj * 128 + n * 16) = w; }
                }
#ifndef OPT_DPP
#define OPT_DPP 1
#endif
#if OPT_DPP
                if (tb) {
                    const int qb = fr & 3; const bool odd = qb & 1, hi2 = qb & 2;
                    bf16* tp = tb + (size_t)(head * 256 + colh + qb) * MROWS + (row - qb);
#pragma unroll
                    for (int bj = 0; bj < 2; ++bj)
#pragma unroll
                        for (int n = 0; n < 2; ++n) {
                            const float f0_ = v[bj][n][0], f1_ = v[bj][n][1], f2_ = v[bj][n][2], f3_ = v[bj][n][3];
                            int x0 = __float_as_int(f0_), x1 = __float_as_int(f1_), x2 = __float_as_int(f2_), x3 = __float_as_int(f3_);
                            int a0, a1, a2, a3, b0, b1, b2, b3;
#define DPPX1(d, s_) asm volatile("s_nop 1\n\tv_mov_b32_dpp %0, %1 quad_perm:[1,0,3,2] row_mask:0xf bank_mask:0xf bound_ctrl:1" : "=&v"(d) : "v"(s_))
#define DPPX2(d, s_) asm volatile("s_nop 1\n\tv_mov_b32_dpp %0, %1 quad_perm:[2,3,0,1] row_mask:0xf bank_mask:0xf bound_ctrl:1" : "=&v"(d) : "v"(s_))
                            DPPX1(a0, x0); DPPX1(a1, x1); DPPX1(a2, x2); DPPX1(a3, x3);
                            x0 = odd ? a1 : x0; x1 = odd ? x1 : a0; x2 = odd ? a3 : x2; x3 = odd ? x3 : a2;
                            DPPX2(b0, x0); DPPX2(b1, x1); DPPX2(b2, x2); DPPX2(b3, x3);
                            if (hi2) { x0 = b2; x1 = b3; } else { x2 = b0; x3 = b1; }
#undef DPPX1
#undef DPPX2
                            u32x2 w; w.x = pk2(__int_as_float(x0), __int_as_float(x1)); w.y = pk2(__int_as_float(x2), __int_as_float(x3));
                            *(u32x2*)(tp + (size_t)(bj * 128 + n * 16) * MROWS) = w;
                        }
                }
#else
                if (tb) {
                    bf16* tp = tb + (size_t)(head * 256 + colh) * MROWS + row;
#pragma unroll
                    for (int bj = 0; bj < 2; ++bj)
#pragma unroll
                        for (int n = 0; n < 2; ++n)
#pragma unroll
                            for (int i = 0; i < 4; ++i) tp[(size_t)(bj * 128 + n * 16 + i) * MROWS] = (bf16)f2bf(v[bj][n][i]);
                }
#endif
            }
    }
};
struct EpiRes {
    static constexpr bool PERM = false, AFTER_DRAIN = false;
    const float* base; float* out;
    __device__ __forceinline__ void operator()(const f32x4 (&acc)[2][2][4][2], const pg8::Unit& u, int wr, int wc, int fr, int fq) const {
        const int col0 = u.pn * 256 + wc * 32 + 4 * fq;
#pragma unroll
        for (int ai = 0; ai < 2; ++ai)
#pragma unroll
            for (int m = 0; m < 4; ++m) {
                const int row = u.pm * 256 + ai * 128 + wr * 64 + m * 16 + fr;
                const float* bp = base + (size_t)row * 1024 + col0;
                float* op = out + (size_t)row * 1024 + col0;
#pragma unroll
                for (int bj = 0; bj < 2; ++bj)
#pragma unroll
                    for (int n = 0; n < 2; ++n) { const f32x4 x = *(const f32x4*)(bp + bj * 128 + n * 16); *(f32x4*)(op + bj * 128 + n * 16) = x * ALPHA + acc[ai][bj][m][n]; }
            }
    }
};
struct EpiPart {
    static constexpr bool PERM = false, AFTER_DRAIN = false;
    float* part;
    __device__ __forceinline__ void operator()(const f32x4 (&acc)[2][2][4][2], const pg8::Unit& u, int wr, int wc, int fr, int fq) const {
        const int col0 = u.pn * 256 + wc * 32 + 4 * fq;
#pragma unroll
        for (int m = 0; m < 4; ++m) {
            const int r = wr * 64 + m * 16 + fr;
            float* op = part + ((size_t)u.pm * 128 + r) * 1024 + col0;
#pragma unroll
            for (int bj = 0; bj < 2; ++bj)
#pragma unroll
                for (int n = 0; n < 2; ++n) *(f32x4*)(op + bj * 128 + n * 16) = acc[0][bj][m][n];
        }
    }
};
struct EpiGU {
    static constexpr bool PERM = false, AFTER_DRAIN = false;
    bf16* hb;
    __device__ __forceinline__ void operator()(const f32x4 (&acc)[2][2][4][2], const pg8::Unit& u, int wr, int wc, int fr, int fq) const {
        const int col0 = u.pn * 128 + wc * 32 + 4 * fq;
#pragma unroll
        for (int ai = 0; ai < 2; ++ai)
#pragma unroll
            for (int m = 0; m < 4; ++m) {
                const int row = u.pm * 256 + ai * 128 + wr * 64 + m * 16 + fr;
                bf16* op = hb + (size_t)row * DFF + col0;
#pragma unroll
                for (int n = 0; n < 2; ++n) {
                    const f32x4 g = acc[ai][0][m][n], up = acc[ai][1][m][n]; float r[4];
#pragma unroll
                    for (int i = 0; i < 4; ++i) r[i] = g[i] * sigmoidf_(g[i]) * up[i];
                    u32x2 w; w.x = pk2(r[0], r[1]); w.y = pk2(r[2], r[3]); *(u32x2*)(op + n * 16) = w;
                }
            }
    }
};

__device__ __forceinline__ void transpose_item(const float* W, int ldw, int sc0, int k0, bf16* WT, int ldk, int dr0, float scale, LAS float* scr, int lane) {
#pragma unroll 8
    for (int i = 0; i < 32; ++i) { const int kk = 2 * i + (lane >> 5); scr[kk * 33 + (lane & 31)] = W[(size_t)(k0 + kk) * ldw + sc0 + (lane & 31)] * scale; }
    asm volatile("s_waitcnt lgkmcnt(0)" ::: "memory");
    const int c = lane & 7;
#pragma unroll
    for (int j = 0; j < 4; ++j) { const int n = (lane >> 3) + 8 * j; const LAS float* s = scr + (8 * c) * 33 + n;
        u32x4 o; o.x = pk2(s[0 * 33], s[1 * 33]); o.y = pk2(s[2 * 33], s[3 * 33]); o.z = pk2(s[4 * 33], s[5 * 33]); o.w = pk2(s[6 * 33], s[7 * 33]);
        *(u32x4*)(WT + (size_t)(dr0 + n) * ldk + k0 + 8 * c) = o; }
    asm volatile("s_waitcnt lgkmcnt(0)" ::: "memory");
}

__device__ __forceinline__ void p0_prologue(const Args& a, LAS unsigned char* lds) {
    const int tid = opaque_tid(), lane = tid & 63, wave = __builtin_amdgcn_readfirstlane(tid >> 6);
    const int gw = blockIdx.x * 8 + wave, NGW = gridDim.x * 8;
    unsigned char* ws = a.ws;
    LAS float* scr = (LAS float*)(lds + wave * 8704);
    LAS float* wgt = (LAS float*)(lds + 69632);
    for (int idx = tid; idx < 8192; idx += NTHR) { const int k = idx >> 3, c = idx & 7; wgt[c * 1024 + k] = a.w_in[(size_t)k * NCOL_SRC + 4096 + c]; }
    constexpr int I_IN = 16 * 320, I_OUT = 16 * 32, I_G = 16 * 88, I_D = 44 * 32;
    constexpr int NITEMS = I_IN + I_OUT + 2 * I_G + I_D;
    for (int it = gw; it < NITEMS; it += NGW) {
        int r = it;
        if (r < I_IN) { const int kb = r / 320, nb = r % 320; const float sc = ((nb >= 32 && nb < 64) || (nb >= 160 && nb < 192)) ? 0.0625f : 1.f;
            transpose_item(a.w_in, NCOL_SRC, 32 * nb + (nb >= 128 ? 8 : 0), 64 * kb, (bf16*)(ws + WS_WIN), 1024, 32 * nb, sc, scr, lane); continue; } r -= I_IN;
        if (r < I_OUT) { const int kb = r / 32, nb = r % 32; transpose_item(a.w_out, 1024, 32 * nb, 64 * kb, (bf16*)(ws + WS_WOUT), 1024, 32 * nb, 1.f, scr, lane); continue; } r -= I_OUT;
        if (r < I_G) { const int kb = r / 88, nb = r % 88; transpose_item(a.w_gate, DFF, 32 * nb, 64 * kb, (bf16*)(ws + WS_WGU), 1024, 256 * (nb >> 2) + 32 * (nb & 3), 1.f, scr, lane); continue; } r -= I_G;
        if (r < I_G) { const int kb = r / 88, nb = r % 88; transpose_item(a.w_up, DFF, 32 * nb, 64 * kb, (bf16*)(ws + WS_WGU), 1024, 256 * (nb >> 2) + 128 + 32 * (nb & 3), 1.f, scr, lane); continue; } r -= I_G;
        { const int kb = r / 32, nb = r % 32; transpose_item(a.w_down, 1024, 32 * nb, 64 * kb, (bf16*)(ws + WS_WDN), DFF, 32 * nb, 1.f, scr, lane); }
    }
    __syncthreads();
    bf16* XB = (bf16*)(ws + WS_XB); float* G = (float*)(ws + WS_G);
    for (int row = gw; row < MROWS; row += NGW) {
        const float* src = row < ROW_S ? a.x_prompt + (size_t)row * 1024 : (row < ROW_M ? a.x_sample + (size_t)(row - ROW_S) * 1024 : (row < ROW_M + 16 ? a.meta + (size_t)(row - ROW_M) * 1024 : nullptr));
        f32x4 v[4];
#pragma unroll
        for (int j = 0; j < 4; ++j) v[j] = src ? ((const f32x4*)src)[lane + 64 * j] : (f32x4){0.f, 0.f, 0.f, 0.f};
#pragma unroll
        for (int j = 0; j < 4; ++j) { u32x2 w; w.x = pk2(v[j][0], v[j][1]); w.y = pk2(v[j][2], v[j][3]); ((u32x2*)(XB + (size_t)row * 1024))[lane + 64 * j] = w; }
        float mine = 0.f;
#pragma unroll
        for (int c = 0; c < 8; ++c) {
            float d = 0.f;
#pragma unroll
            for (int j = 0; j < 4; ++j) { const f32x4 wv = ((const LAS f32x4*)(wgt + c * 1024))[lane + 64 * j]; d += v[j][0] * wv[0] + v[j][1] * wv[1] + v[j][2] * wv[2] + v[j][3] * wv[3]; }
            d = wave_sum(d);
            if (lane == c) mine = d;
        }
        if (lane < 8) G[(size_t)row * 8 + lane] = mine + a.b_in[4096 + lane];
    }
    float* rot = (float*)(ws + WS_ROT);
    for (int e = blockIdx.x * NTHR + tid; e < NPOS * 128; e += gridDim.x * NTHR) {
        const int p = e >> 7, j = e & 127;
        double inv = 1.0, rr = 0.930572040929699;
#pragma unroll
        for (int bit = 0; bit < 7; ++bit) { if ((j >> bit) & 1) inv *= rr; rr *= rr; }
        const double pos = (p == 2064) ? 16384.0 : (double)p;
        const double t = pos * inv * 0.15915494309189535; const double fr = t - floor(t);
        const float f = (float)fr;
        rot[2 * e] = __builtin_amdgcn_cosf(f); rot[2 * e + 1] = __builtin_amdgcn_sinf(f);
    }
}

__device__ __forceinline__ void gate_scan(const Args& a, LAS unsigned char* lds, int bh) {
    const int tid = opaque_tid(), b = bh >> 2, h = bh & 3;
    const float* G = (const float*)(a.ws + WS_G);
    float* SF = (float*)(a.ws + WS_SF) + (size_t)bh * SCN; float* SM = (float*)(a.ws + WS_SM) + (size_t)bh * SCN;
    float F = 0.f, M = 0.f;
    if (tid == 0) { SF[0] = 0.f; SM[0] = 0.f; }
    for (int s = 0; s < NMETA; ++s) { const float gi = G[(size_t)(ROW_M + s) * 8 + h], gf = logsigf_(G[(size_t)(ROW_M + s) * 8 + 4 + h]); F += gf; M = fmaxf(M + gf, gi); if (tid == 0) { SF[s + 1] = F; SM[s + 1] = M; } }
    const int row = b * 2048 + 4 * tid;
    float f[4], gi[4], pa = 0.f, pc = -INFINITY;
#pragma unroll
    for (int k = 0; k < 4; ++k) { gi[k] = G[(size_t)(row + k) * 8 + h]; f[k] = logsigf_(G[(size_t)(row + k) * 8 + 4 + h]); pc = fmaxf(pc + f[k], gi[k]); pa += f[k]; }
    LAS float* sa = (LAS float*)lds; LAS float* sc = sa + 512;
    for (int off = 1; off < 512; off <<= 1) {
        sa[tid] = pa; sc[tid] = pc; __syncthreads();
        float la = 0.f, lc = -INFINITY; const bool has = tid >= off;
        if (has) { la = sa[tid - off]; lc = sc[tid - off]; }
        __syncthreads();
        if (has) { pc = fmaxf(lc + pa, pc); pa = la + pa; }
    }
    sa[tid] = pa; sc[tid] = pc; __syncthreads();
    float ea = 0.f, ec = -INFINITY; if (tid > 0) { ea = sa[tid - 1]; ec = sc[tid - 1]; }
    __syncthreads();
    float Fb = F + ea, Mb = fmaxf(M + ea, ec);
#pragma unroll
    for (int k = 0; k < 4; ++k) { Fb += f[k]; Mb = fmaxf(Mb + f[k], gi[k]); SF[17 + 4 * tid + k] = Fb; SM[17 + 4 * tid + k] = Mb; }
}

__device__ __forceinline__ f32x4 mfma16(bf16x8 x, bf16x8 y, f32x4 c) { return __builtin_amdgcn_mfma_f32_16x16x32_bf16(x, y, c, 0, 0, 0); }

template <bool ML>
__device__ __forceinline__ void mixer_unit(const Args& a, LAS unsigned char* lds, int b, int h, int slice) {
    constexpr int NDB = ML ? 5 : 4;
    int tid_ = threadIdx.x; asm volatile("" : "+v"(tid_));
    const int tid = tid_, w = __builtin_amdgcn_readfirstlane(tid >> 6), lane = tid & 63, fr = lane & 15, fq = lane >> 4;
    unsigned char* ws = a.ws;
    const bf16* Q = (const bf16*)(ws + WS_PROJ + (size_t)(ML ? 0 : 3) * SLOT);
    const bf16* Kr = (const bf16*)(ws + WS_PROJ + (size_t)(ML ? 1 : 4) * SLOT);
    const bf16* KT = (const bf16*)(ws + WS_PROJ + (size_t)(ML ? 8 : 10) * SLOT);
    const bf16* VT = (const bf16*)(ws + WS_PROJ + (size_t)(ML ? 9 : 11) * SLOT);
    bf16* Hout = (bf16*)(ws + (ML ? WS_HA : WS_HB));
    const float* G = (const float*)(ws + WS_G);
    const int bh = b * 4 + h;
    const float* SF = (const float*)(ws + WS_SF) + (size_t)bh * SCN; const float* SM = (const float*)(ws + WS_SM) + (size_t)bh * SCN;
    const float lg = log1pf(-exp2f(-5.f - (float)h));
    const int tb = w < 4 ? w : 11 - w;
    const int swz = ((fr >> 3) & 1) << 5;
    const int boff = (fr * 64 + fq * 16) ^ swz;
    const int vof0 = (fr * 64 + fq * 8) ^ swz, vof1 = (fr * 64 + 32 + fq * 8) ^ swz;
    const bf16* KTb = KT + (size_t)(h * 256 + w * 32 + fr) * MROWS + 4 * fq;
    const bf16* VTb = VT + (size_t)(h * 256 + slice * 64) * MROWS;
    int kR[2], kC[2];
#pragma unroll
    for (int i = 0; i < 2; ++i) pg8::stage_rc(tid * 16 + i * 8192, kR[i], kC[i]);
    const bf16* Ksrc0 = Kr + (size_t)kR[0] * 1024 + h * 256 + kC[0]; const bf16* Ksrc1 = Kr + (size_t)kR[1] * 1024 + h * 256 + kC[1];
    int vsrc[2];
#pragma unroll
    for (int j = 0; j < 2; ++j) { const int idx = 2 * w + j, t = idx >> 3, st = idx & 7; const int p = 16 * lane, ob = p ^ (((p >> 9) & 1) << 5), rr = ob >> 6, cc = (ob & 63) >> 1;
        vsrc[j] = ((st >> 1) * 16 + rr) * MROWS + t * 64 + (st & 1) * 32 + cc; }
#define MIX_DMA_TO(c_, buf_) do { const int r0n_ = b * 2048 + 128 * (c_); \
        _Pragma("unroll") for (int kt = 0; kt < 4; ++kt) { \
            __builtin_amdgcn_global_load_lds((const unsigned*)(Ksrc0 + (size_t)r0n_ * 1024 + kt * 64), (LAS unsigned*)(lds + KOFF + kt * 16384 + w * 1024), 16, 0, 0); \
            __builtin_amdgcn_global_load_lds((const unsigned*)(Ksrc1 + (size_t)r0n_ * 1024 + kt * 64), (LAS unsigned*)(lds + KOFF + kt * 16384 + w * 1024 + 8192), 16, 0, 0); } \
        _Pragma("unroll") for (int j = 0; j < 2; ++j) { const int idx = 2 * w + j; \
            __builtin_amdgcn_global_load_lds((const unsigned*)(VTb + vsrc[j] + r0n_), (LAS unsigned*)(lds + VOFF + (buf_) * VBUF + (idx >> 3) * 10240 + (idx & 7) * 1024), 16, 0, 0); } \
    } while (0)
#define MIX_DMA(c_) MIX_DMA_TO(c_, (c_) & 1)
#define MIX_ARRAYS_TO(c_, buf_) do { LAS float* ar_ = (LAS float*)(lds + AOFF + (buf_) * ABUF); const int t0n_ = 16 + 128 * (c_), tj_ = tid & 127; \
        if (ML) { const float Fp = SF[t0n_], Mp = SM[t0n_], Fe = SF[t0n_ + 128], Me = SM[t0n_ + 128]; \
            const float Fj = SF[t0n_ + 1 + tj_], Mj = SM[t0n_ + 1 + tj_], gi = G[(size_t)(b * 2048 + 128 * (c_) + tj_) * 8 + h]; \
            const float v0_ = Fj - Mj, v1_ = gi - Fj, v2_ = __expf(Fj - Fp + Mp - Mj), v3_ = __expf(Fe - Fj + gi - Me), v4_ = __expf(-Mj); \
            if (tid < 128) { ar_[tid] = v0_; ar_[128 + tid] = v1_; ar_[256 + tid] = v2_; ar_[384 + tid] = v3_; ar_[512 + tid] = v4_; } \
        } else if (tid < 128) { ar_[tid] = (float)tid * lg; ar_[128 + tid] = -(float)tid * lg; ar_[256 + tid] = __expf((float)(tid + 1) * lg); ar_[384 + tid] = __expf((float)(127 - tid) * lg); ar_[512 + tid] = 0.f; } \
    } while (0)
#define MIX_ARRAYS(c_) MIX_ARRAYS_TO(c_, (c_) & 1)

    f32x4 Cacc[2][NDB];
#pragma unroll
    for (int xb = 0; xb < 2; ++xb)
#pragma unroll
        for (int yb = 0; yb < NDB; ++yb) Cacc[xb][yb] = (f32x4){0.f, 0.f, 0.f, 0.f};

    if (ML) {
        { const int bufi = tid >> 8, tile = (tid >> 7) & 1, rr = (tid >> 3) & 15, pc = tid & 7; unsigned val = rr == 0 ? 0x3F803F80u : 0u; asm volatile("" : "+v"(val));
            *(LAS u32x4*)(lds + VOFF + bufi * VBUF + tile * 10240 + pg8::lds_byte(64 + rr, pc * 8)) = (u32x4){val, val, val, val}; }
    }
#define MIX_LOADKT(nks, rbase) do { _Pragma("unroll") for (int xb = 0; xb < 2; ++xb) _Pragma("unroll") for (int ks = 0; ks < (nks); ++ks) { \
        const u32x2 lo_ = *(const u32x2*)(KTb + (size_t)xb * 16 * MROWS + (rbase) + 32 * ks), hi_ = *(const u32x2*)(KTb + (size_t)xb * 16 * MROWS + (rbase) + 32 * ks + 16); \
        kxp[xb][ks] = (u32x4){lo_.x, lo_.y, hi_.x, hi_.y}; } } while (0)
#define MIX_PACKKT(nks, wsv_) do { _Pragma("unroll") for (int ks = 0; ks < (nks); ++ks) { \
        const f32x4 w0 = *(const LAS f32x4*)((wsv_) + 32 * ks + 4 * fq), w1 = *(const LAS f32x4*)((wsv_) + 32 * ks + 16 + 4 * fq); \
        _Pragma("unroll") for (int xb = 0; xb < 2; ++xb) { const u32x4 r_ = kxp[xb][ks]; u32x4 p; \
            p.x = pk2(bf2f(r_.x & 0xffffu) * w0[0], bf2f(r_.x >> 16) * w0[1]); p.y = pk2(bf2f(r_.y & 0xffffu) * w0[2], bf2f(r_.y >> 16) * w0[3]); \
            p.z = pk2(bf2f(r_.z & 0xffffu) * w1[0], bf2f(r_.z >> 16) * w1[1]); p.w = pk2(bf2f(r_.w & 0xffffu) * w1[2], bf2f(r_.w >> 16) * w1[3]); \
            kxp[xb][ks] = p; } } } while (0)
#define MIX_STEPC(nks, vbase, wcv) do { \
        _Pragma("unroll") for (int xb = 0; xb < 2; ++xb) _Pragma("unroll") for (int yb = 0; yb < NDB; ++yb) Cacc[xb][yb] = Cacc[xb][yb] * (wcv); \
        _Pragma("unroll") for (int ks = 0; ks < (nks); ++ks) { \
            _Pragma("unroll") for (int yb = 0; yb < NDB; ++yb) { \
                const LAS unsigned char* vp = (vbase) + (ks >> 1) * 10240 + (2 * yb + (ks & 1)) * 1024; \
                u32x4 q; { const u32x2 lo = *(const LAS u32x2*)(vp + vof0), hi = *(const LAS u32x2*)(vp + vof1); q.x = lo.x; q.y = lo.y; q.z = hi.x; q.w = hi.y; } \
                const bf16x8 vf = __builtin_bit_cast(bf16x8, q); \
                _Pragma("unroll") for (int xb = 0; xb < 2; ++xb) Cacc[xb][yb] = mfma16(__builtin_bit_cast(bf16x8, kxp[xb][ks]), vf, Cacc[xb][yb]); } \
            __builtin_amdgcn_sched_barrier(0); } \
    } while (0)
#define MIX_WRITE_CBF() do { \
        _Pragma("unroll") for (int xb = 0; xb < 2; ++xb) _Pragma("unroll") for (int yb = 0; yb < NDB; ++yb) { \
            u32x2 o; o.x = pk2(Cacc[xb][yb][0], Cacc[xb][yb][1]); o.y = pk2(Cacc[xb][yb][2], Cacc[xb][yb][3]); \
            *(LAS u32x2*)(lds + COFF + (w >> 1) * 10240 + (2 * yb + (w & 1)) * 1024 + ((fr * 64 + (16 * xb + 4 * fq) * 2) ^ swz)) = o; } \
    } while (0)

    u32x4 kxp[2][4];
    if (tid < 32) {
        float wv = 0.f;
        if (tid < 16) {
            if (ML) { const float Fs = SF[tid + 1], F16 = SF[16], M16 = SM[16], gi = G[(size_t)(ROW_M + tid) * 8 + h]; wv = __expf(F16 - Fs + gi - M16); }
            else wv = __expf((float)(15 - tid) * lg);
        }
        ((LAS float*)(lds + AOFF + ABUF))[384 + tid] = wv;
    }
    if (tid < 256) { const int dv = tid >> 2, s0 = (tid & 3) * 8;
        *(LAS u32x4*)(lds + VOFF + VBUF + pg8::lds_byte(dv, s0)) = *(const u32x4*)(VTb + (size_t)dv * MROWS + ROW_M + s0); }
    MIX_LOADKT(1, ROW_M);
    MIX_DMA(0);
    MIX_ARRAYS(0);
    __syncthreads();
    MIX_PACKKT(1, (LAS float*)(lds + AOFF + ABUF) + 384);
    MIX_STEPC(1, lds + VOFF + VBUF, 0.f);
    bf16x8 qa[8];
    { const bf16* qp = Q + (size_t)(b * 2048 + 16 * tb + fr) * 1024 + h * 256 + 8 * fq;
#pragma unroll
        for (int ks = 0; ks < 8; ++ks) qa[ks] = *(const bf16x8*)(qp + 32 * ks); }
    __syncthreads();
    MIX_WRITE_CBF();

    for (int c = 0; c < 16; ++c) {
        const int r0 = b * 2048 + 128 * c;
        const LAS unsigned char* vb = lds + VOFF + (c & 1) * VBUF;
        const LAS float* rowa = (const LAS float*)(lds + AOFF + (c & 1) * ABUF); const LAS float* colb = rowa + 128; const LAS float* wint = rowa + 256; const LAS float* wsv = rowa + 384; const LAS float* flo = rowa + 512;
        float wc;
        if (ML) { const int t0 = 16 + 128 * c; wc = __expf(SF[t0 + 128] - SF[t0] + SM[t0] - SM[t0 + 128]); } else wc = __expf(128.f * lg);
        const int tl = 16 * tb + fr, tq = tl - 4 * fq; const float ra = rowa[tl];
        bf16x8 sp[4];
#pragma unroll
        for (int hs = 0; hs < 2; ++hs) {
            if (hs == 0 || tb >= 4) {
                f32x4 S[4];
#pragma unroll
                for (int nb = 0; nb < 4; ++nb) S[nb] = (f32x4){0.f, 0.f, 0.f, 0.f};
#pragma unroll
                for (int ks = 0; ks < 8; ++ks)
#pragma unroll
                    for (int nb = 0; nb < 4; ++nb) {
                        const bf16x8 kf = *(const LAS bf16x8*)(lds + KOFF + (ks >> 1) * 16384 + (2 * (4 * hs + nb) + (ks & 1)) * 1024 + boff);
                        S[nb] = mfma16(kf, qa[ks], S[nb]);
                    }
#pragma unroll
                for (int k2 = 0; k2 < 2; ++k2) {
                    u32x4 p;
#pragma unroll
                    for (int hf = 0; hf < 2; ++hf) {
                        const int nbl = 2 * k2 + hf, nb = 4 * hs + nbl; const f32x4 cb = *(const LAS f32x4*)(colb + 16 * nb + 4 * fq); float r[4];
#pragma unroll
                        for (int e = 0; e < 4; ++e) { const float d = __expf(ra + cb[e]); r[e] = ((16 * nb + e) <= tq) ? S[nbl][e] * d : 0.f; }
                        if (hf == 0) { p.x = pk2(r[0], r[1]); p.y = pk2(r[2], r[3]); } else { p.z = pk2(r[0], r[1]); p.w = pk2(r[2], r[3]); }
                    }
                    sp[2 * hs + k2] = __builtin_bit_cast(bf16x8, p);
                }
            } else { sp[2] = (bf16x8){0, 0, 0, 0, 0, 0, 0, 0}; sp[3] = (bf16x8){0, 0, 0, 0, 0, 0, 0, 0}; }
            __builtin_amdgcn_sched_barrier(0);
        }
        asm volatile("s_waitcnt lgkmcnt(0)" ::: "memory"); __builtin_amdgcn_s_barrier(); asm volatile("" ::: "memory");
        const int cn = c < 15 ? c + 1 : 15;
        MIX_DMA_TO(cn, (c + 1) & 1);
        MIX_LOADKT(4, r0);
        __builtin_amdgcn_sched_barrier(0);
        const float wi = wint[tl];
        float scale = 1.f;
        bf16* hp = Hout + (size_t)(r0 + tl) * 1024 + h * 256 + slice * 64 + 4 * fq;
#pragma unroll
        for (int dbi = 0; dbi < NDB; ++dbi) {
            const int db = ML ? (dbi == 0 ? 4 : dbi - 1) : dbi;
            f32x4 o = (f32x4){0.f, 0.f, 0.f, 0.f};
#pragma unroll
            for (int ks = 0; ks < 8; ++ks) {
                const bf16x8 cf = *(const LAS bf16x8*)(lds + COFF + (ks >> 1) * 10240 + (2 * db + (ks & 1)) * 1024 + boff);
                o = mfma16(cf, qa[ks], o);
            }
            o = o * wi;
#pragma unroll
            for (int k2 = 0; k2 < 2; ++k2) {
                const LAS unsigned char* vp = vb + (2 * db + (k2 & 1)) * 1024;
                u32x4 q; { const u32x2 lo = *(const LAS u32x2*)(vp + vof0), hi = *(const LAS u32x2*)(vp + vof1); q.x = lo.x; q.y = lo.y; q.z = hi.x; q.w = hi.y; }
                o = mfma16(__builtin_bit_cast(bf16x8, q), sp[k2], o);
            }
            if (tb >= 4) {
#pragma unroll
                for (int k2 = 2; k2 < 4; ++k2) {
                    const LAS unsigned char* vp = vb + 10240 + (2 * db + (k2 & 1)) * 1024;
                    u32x4 q; { const u32x2 lo = *(const LAS u32x2*)(vp + vof0), hi = *(const LAS u32x2*)(vp + vof1); q.x = lo.x; q.y = lo.y; q.z = hi.x; q.w = hi.y; }
                    o = mfma16(__builtin_bit_cast(bf16x8, q), sp[k2], o);
                }
            }
            if (ML && dbi == 0) { const float den = __shfl(o[0], fr); scale = 1.f / fmaxf(fabsf(den), flo[tl]); }
            else { u32x2 ov; ov.x = pk2(o[0] * scale, o[1] * scale); ov.y = pk2(o[2] * scale, o[3] * scale); *(u32x2*)(hp + 16 * db) = ov; }
            __builtin_amdgcn_sched_barrier(0);
        }
        MIX_PACKKT(4, wsv);
        __builtin_amdgcn_sched_barrier(0);
        {
            const bf16* qp = Q + (size_t)(b * 2048 + 128 * cn + 16 * tb + fr) * 1024 + h * 256 + 8 * fq;
#pragma unroll
            for (int ks = 0; ks < 8; ++ks) qa[ks] = *(const bf16x8*)(qp + 32 * ks);
            MIX_ARRAYS_TO(cn, (c + 1) & 1);
        }
        __builtin_amdgcn_sched_barrier(0);
        MIX_STEPC(4, vb, wc);
        asm volatile("s_waitcnt vmcnt(0)" ::: "memory");
        __syncthreads();
        MIX_WRITE_CBF();
    }
    float* oC = a.out + (ML ? O_PC : O_PS) + (size_t)bh * 65536;
#pragma unroll
    for (int xb = 0; xb < 2; ++xb)
#pragma unroll
        for (int yb = 0; yb < 4; ++yb)
#pragma unroll
            for (int e = 0; e < 4; ++e) oC[(size_t)(32 * w + 16 * xb + 4 * fq + e) * 256 + slice * 64 + 16 * yb + fr] = Cacc[xb][yb][e];
    if (ML && slice == 0) {
        if (fr == 0) {
#pragma unroll
            for (int xb = 0; xb < 2; ++xb)
#pragma unroll
                for (int e = 0; e < 4; ++e) a.out[O_PN + (size_t)bh * 256 + 32 * w + 16 * xb + 4 * fq + e] = Cacc[xb][NDB - 1][e];
        }
        if (tid == 0) a.out[O_PM + bh] = SM[2064];
    }
    __syncthreads();
#undef MIX_STEPC
#undef MIX_WRITE_CBF
#undef MIX_LOADKT
#undef MIX_PACKKT
#undef MIX_DMA
#undef MIX_ARRAYS
#undef MIX_DMA_TO
#undef MIX_ARRAYS_TO
}

__device__ __forceinline__ void sample_unit(const Args& a, LAS unsigned char* lds, int branch, int n, int h) {
    int tid_ = threadIdx.x; asm volatile("" : "+v"(tid_));
    const int tid = tid_, w = __builtin_amdgcn_readfirstlane(tid >> 6), lane = tid & 63;
    unsigned char* ws = a.ws; const bool ML = branch == 0;
    const int row = ROW_S + n, nh = n * 4 + h;
    const bf16* Q = (const bf16*)(ws + WS_PROJ + (size_t)(ML ? 0 : 3) * SLOT);
    const bf16* Kr = (const bf16*)(ws + WS_PROJ + (size_t)(ML ? 1 : 4) * SLOT);
    const bf16* VT = (const bf16*)(ws + WS_PROJ + (size_t)(ML ? 9 : 11) * SLOT);
    bf16* Hout = (bf16*)(ws + (ML ? WS_HA : WS_HB));
    const float* G = (const float*)(ws + WS_G);
    const float* inC = (ML ? a.st_C : a.st_S) + (size_t)nh * 65536;
    float* outC = a.out + (ML ? O_SC : O_SS) + (size_t)nh * 65536;
    float ca, cb, mnew = 0.f;
    if (ML) { const float gi = G[(size_t)row * 8 + h], gf = logsigf_(G[(size_t)row * 8 + 4 + h]), m = a.st_m[nh]; mnew = fmaxf(gf + m, gi); ca = expf(gf + m - mnew); cb = expf(gi - mnew); }
    else { ca = 1.f - exp2f(-5.f - (float)h); cb = 1.f; }
    LAS float* sq = (LAS float*)lds; LAS float* sk = sq + 256; LAS float* sv = sq + 512; LAS float* red = sq + 768; LAS float* sden = red + 2048;
    if (tid < 256) { sq[tid] = bf2f(Q[(size_t)row * 1024 + h * 256 + tid]); sk[tid] = cb * bf2f(Kr[(size_t)row * 1024 + h * 256 + tid]); sv[tid] = bf2f(VT[(size_t)(h * 256 + tid) * MROWS + row]); }
    __syncthreads();
    const f32x4 v4 = ((const LAS f32x4*)sv)[lane];
    f32x4 acc = (f32x4){0.f, 0.f, 0.f, 0.f};
#pragma unroll 8
    for (int i = 0; i < 32; ++i) {
        const int r = w + 8 * i;
        const f32x4 c4 = ((const f32x4*)(inC + (size_t)r * 256))[lane];
        const f32x4 cn = c4 * ca + v4 * sk[r];
        ((f32x4*)(outC + (size_t)r * 256))[lane] = cn;
        acc += cn * sq[r];
    }
    ((LAS f32x4*)(red + w * 256))[lane] = acc;
    float dpart = 0.f;
    if (ML && tid < 256) { const float nn = ca * a.st_n[(size_t)nh * 256 + tid] + sk[tid]; a.out[O_SN + (size_t)nh * 256 + tid] = nn; dpart = sq[tid] * nn; }
    if (ML) { dpart = wave_sum(dpart); if (lane == 0) sden[w] = dpart; }
    __syncthreads();
    if (tid < 256) {
        float o = 0.f;
#pragma unroll
        for (int k = 0; k < 8; ++k) o += red[k * 256 + tid];
        if (ML) { const float den = sden[0] + sden[1] + sden[2] + sden[3]; o = o / fmaxf(fabsf(den), expf(-mnew)); }
        Hout[(size_t)row * 1024 + h * 256 + tid] = (bf16)f2bf(o);
    }
    if (ML && tid == 0) a.out[O_SM + nh] = mnew;
    __syncthreads();
}

__device__ __forceinline__ void p3_row_load(const bf16* HA, const bf16* HB, const bf16* MO, const bf16* RG, const bf16* GA, const bf16* GB, int row, int lane, u32x2 (&d)[4][6]) {
#pragma unroll
    for (int hh = 0; hh < 4; ++hh) { const size_t off = (size_t)row * 1024 + hh * 256;
        d[hh][0] = ((const u32x2*)(HA + off))[lane]; d[hh][1] = ((const u32x2*)(HB + off))[lane]; d[hh][2] = ((const u32x2*)(MO + off))[lane];
        d[hh][3] = ((const u32x2*)(RG + off))[lane]; d[hh][4] = ((const u32x2*)(GA + off))[lane]; d[hh][5] = ((const u32x2*)(GB + off))[lane]; }
}
__device__ __forceinline__ void p3_row_compute(const Args& a, bf16* MG, int row, int lane, const u32x2 (&d)[4][6]) {
#pragma unroll
    for (int hh = 0; hh < 4; ++hh) {
        const size_t off = (size_t)row * 1024 + hh * 256;
        const u32x2 ra = d[hh][0], rb = d[hh][1], go = d[hh][2], gg = d[hh][3], g1 = d[hh][4], g2 = d[hh][5];
        float xa[4] = {bf2f(ra.x & 0xffffu), bf2f(ra.x >> 16), bf2f(ra.y & 0xffffu), bf2f(ra.y >> 16)};
        float xb[4] = {bf2f(rb.x & 0xffffu), bf2f(rb.x >> 16), bf2f(rb.y & 0xffffu), bf2f(rb.y >> 16)};
        const float ma = wave_sum((xa[0] + xa[1]) + (xa[2] + xa[3])) * (1.f / 256.f), mb = wave_sum((xb[0] + xb[1]) + (xb[2] + xb[3])) * (1.f / 256.f);
        float qa = 0.f, qb = 0.f;
#pragma unroll
        for (int i = 0; i < 4; ++i) { xa[i] -= ma; xb[i] -= mb; qa += xa[i] * xa[i]; qb += xb[i] * xb[i]; }
        const float rsa = 1.f / sqrtf(wave_sum(qa) * (1.f / 256.f) + LN_EPS), rsb = 1.f / sqrtf(wave_sum(qb) * (1.f / 256.f) + LN_EPS);
        const f32x4 ga = ((const f32x4*)(a.ml_g + hh * 256))[lane], gb = ((const f32x4*)(a.rt_g + hh * 256))[lane];
        const float fo[4] = {bf2f(go.x & 0xffffu), bf2f(go.x >> 16), bf2f(go.y & 0xffffu), bf2f(go.y >> 16)};
        const float fg[4] = {bf2f(gg.x & 0xffffu), bf2f(gg.x >> 16), bf2f(gg.y & 0xffffu), bf2f(gg.y >> 16)};
        const float f1[4] = {bf2f(g1.x & 0xffffu), bf2f(g1.x >> 16), bf2f(g1.y & 0xffffu), bf2f(g1.y >> 16)};
        const float f2[4] = {bf2f(g2.x & 0xffffu), bf2f(g2.x >> 16), bf2f(g2.y & 0xffffu), bf2f(g2.y >> 16)};
        float r[4];
#pragma unroll
        for (int i = 0; i < 4; ++i) r[i] = f1[i] * (xa[i] * rsa * ga[i] * fo[i]) + f2[i] * (xb[i] * rsb * gb[i] * fg[i]);
        u32x2 o; o.x = pk2(r[0], r[1]); o.y = pk2(r[2], r[3]);
        ((u32x2*)(MG + off))[lane] = o;
    }
}
__device__ __forceinline__ void p3_merge(const Args& a) {
    const int tid = opaque_tid(), lane = tid & 63, wave = tid >> 6; const int gw = blockIdx.x * 8 + wave, NGW = gridDim.x * 8;
    unsigned char* ws = a.ws;
    const bf16* HA = (const bf16*)(ws + WS_HA); const bf16* HB = (const bf16*)(ws + WS_HB);
    const bf16* MO = (const bf16*)(ws + WS_PROJ + 2 * SLOT); const bf16* RG = (const bf16*)(ws + WS_PROJ + 5 * SLOT);
    const bf16* GA = (const bf16*)(ws + WS_PROJ + 6 * SLOT); const bf16* GB = (const bf16*)(ws + WS_PROJ + 7 * SLOT);
    bf16* MG = (bf16*)(ws + WS_XB);
    for (int row = ROW_V + gw; row < MROWS; row += NGW) {
#pragma unroll
        for (int hh = 0; hh < 4; ++hh) ((u32x2*)(MG + (size_t)row * 1024 + hh * 256))[lane] = (u32x2){0u, 0u};
    }
    for (int row = gw; row < ROW_V; row += 2 * NGW) {
        const int rowB = row + NGW; const bool hasB = rowB < ROW_V;
        u32x2 dA[4][6], dB[4][6];
        p3_row_load(HA, HB, MO, RG, GA, GB, row, lane, dA);
        p3_row_load(HA, HB, MO, RG, GA, GB, hasB ? rowB : row, lane, dB);
        p3_row_compute(a, MG, row, lane, dA);
        if (hasB) p3_row_compute(a, MG, rowB, lane, dB);
    }
}
template <bool FINAL>
__device__ __forceinline__ void ln_row_load(const float* src, const float* sbase, const float* part, int npart, int row, int lane, f32x4 (&v)[4]) {
    if (row < ROW_S) {
#pragma unroll
        for (int j = 0; j < 4; ++j) v[j] = ((const f32x4*)(src + (size_t)row * 1024))[lane + 64 * j];
    } else {
        const int r = row - ROW_S;
#pragma unroll
        for (int j = 0; j < 4; ++j) v[j] = ((const f32x4*)(sbase + (size_t)r * 1024))[lane + 64 * j] * ALPHA;
        for (int p = 0; p < npart; ++p)
#pragma unroll
            for (int j = 0; j < 4; ++j) v[j] += ((const f32x4*)(part + ((size_t)p * 128 + r) * 1024))[lane + 64 * j];
    }
}
template <bool FINAL>
__device__ __forceinline__ void ln_row_finish(const Args& a, int row, int lane, f32x4 (&v)[4], const f32x4 (&gv)[4], const f32x4 (&bv)[4]) {
    float* X1 = (float*)(a.ws + WS_X1); bf16* X1B = (bf16*)(a.ws + WS_X1B);
    float s = 0.f;
#pragma unroll
    for (int j = 0; j < 4; ++j) s += (v[j][0] + v[j][1]) + (v[j][2] + v[j][3]);
    const float mean = wave_sum(s) * (1.f / 1024.f); float q = 0.f;
#pragma unroll
    for (int j = 0; j < 4; ++j) { v[j] = v[j] - mean; q += (v[j][0] * v[j][0] + v[j][1] * v[j][1]) + (v[j][2] * v[j][2] + v[j][3] * v[j][3]); }
    const float rstd = 1.f / sqrtf(wave_sum(q) * (1.f / 1024.f) + LN_EPS);
#pragma unroll
    for (int j = 0; j < 4; ++j) {
        const f32x4 y = v[j] * rstd * gv[j] + bv[j];
        if (FINAL) { ((f32x4*)(a.out + (size_t)row * 1024))[lane + 64 * j] = y; }
        else { ((f32x4*)(X1 + (size_t)row * 1024))[lane + 64 * j] = y; u32x2 o; o.x = pk2(y[0], y[1]); o.y = pk2(y[2], y[3]); ((u32x2*)(X1B + (size_t)row * 1024))[lane + 64 * j] = o; }
    }
}
template <bool FINAL>
__device__ __forceinline__ void ln_phase(const Args& a, const float* src, const float* g, const float* bta, const float* sbase, const float* part, int npart) {
    const int tid = opaque_tid(), lane = tid & 63, wave = tid >> 6; const int gw = blockIdx.x * 8 + wave, NGW = gridDim.x * 8;
    bf16* X1B = (bf16*)(a.ws + WS_X1B);
    f32x4 gv[4], bv[4];
#pragma unroll
    for (int j = 0; j < 4; ++j) { gv[j] = ((const f32x4*)g)[lane + 64 * j]; bv[j] = ((const f32x4*)bta)[lane + 64 * j]; }
    if (!FINAL) for (int row = ROW_V + gw; row < MROWS; row += NGW) {
#pragma unroll
        for (int j = 0; j < 4; ++j) ((u32x2*)(X1B + (size_t)row * 1024))[lane + 64 * j] = (u32x2){0u, 0u};
    }
    for (int row = gw; row < ROW_V; row += 2 * NGW) {
        const int rowB = row + NGW; const bool hasB = rowB < ROW_V;
        f32x4 vA[4], vB[4];
        ln_row_load<FINAL>(src, sbase, part, npart, row, lane, vA);
        ln_row_load<FINAL>(src, sbase, part, npart, hasB ? rowB : row, lane, vB);
        ln_row_finish<FINAL>(a, row, lane, vA, gv, bv);
        if (hasB) ln_row_finish<FINAL>(a, rowB, lane, vB, gv, bv);
    }
}

#ifndef REPEAT_SAMPLE
#define REPEAT_SAMPLE 1
#endif
#ifndef REPEAT_PROMPT
#define REPEAT_PROMPT 1
#endif
__global__ void __launch_bounds__(NTHR, 2) hybrid_fwd(Args a_) {
    extern __shared__ __attribute__((aligned(16))) unsigned char lds_raw[];
    LAS unsigned char* lds = (LAS unsigned char*)lds_raw;
    cg::grid_group grid = cg::this_grid();
    const int lo = a_.ph_lo, hi = a_.ph_hi;
#define FRESH_ARGS() auto kp_ = __builtin_amdgcn_kernarg_segment_ptr(); asm volatile("" : "+s"(kp_)); const Args& a = *(const Args*)kp_; unsigned char* ws = a.ws;
#ifdef DBG_STOP
#define PH_MASK ((2 << DBG_STOP) - 1)
#endif
#ifndef PH_MASK
#define PH_MASK 0x1ff
#endif
#define IN(k) (((PH_MASK >> (k)) & 1) && lo <= (k) && (k) < hi)
#ifndef REPEAT_MASK
#define REPEAT_MASK 0
#endif
#define PH_BEGIN(k) for (int r_ = 0; r_ < (((REPEAT_MASK >> (k)) & 1) ? 2 : 1); ++r_) { if (IN(k))
#define PH_END(k) if ((r_ == 0 && ((REPEAT_MASK >> (k)) & 1)) || (IN(k) && IN((k) + 1))) grid.sync(); }
    PH_BEGIN(0) { FRESH_ARGS() p0_prologue(a, lds); } PH_END(0)
    PH_BEGIN(1) { FRESH_ARGS()
        if (blockIdx.x < 32) { gate_scan(a, lds, blockIdx.x); __syncthreads(); }
        const pg8::Gemm g = mk_gemm((const bf16*)(ws + WS_XB), (const bf16*)(ws + WS_WIN), MROWS, 10240, 1024); pg8::StaticOrder S; S.init(MROWS, 10240, gridDim.x, blockIdx.x);
        EpiProj E{ws, a.b_in};
        pg8::gemm_phase<EpiProj, pg8::StaticOrder, true, true>(lds, g, S, E);
    }
    PH_END(1)
    PH_BEGIN(2) { FRESH_ARGS()
        for (int rp_ = 0; rp_ < REPEAT_PROMPT; ++rp_)
        for (int u = blockIdx.x; u < 256; u += gridDim.x) {
            const int combo = (u & 7) * 8 + ((u >> 3) & 7), slice = u >> 6;
            const int branch = combo >> 5, b = (combo >> 2) & 7, h = combo & 3;
            if (branch == 0) mixer_unit<true>(a, lds, b, h, slice); else mixer_unit<false>(a, lds, b, h, slice);
        }
        for (int rs_ = 0; rs_ < REPEAT_SAMPLE; ++rs_)
        for (int u = blockIdx.x; u < 1024; u += gridDim.x) sample_unit(a, lds, u >> 9, (u & 511) >> 2, u & 3);
    }
    PH_END(2)
    PH_BEGIN(3) { FRESH_ARGS() p3_merge(a); } PH_END(3)
    PH_BEGIN(4) { FRESH_ARGS()
        { const pg8::Gemm g = mk_gemm((const bf16*)(ws + WS_XB), (const bf16*)(ws + WS_WOUT), ROW_S, 1024, 1024); pg8::StaticOrder S; S.init(ROW_S, 1024, gridDim.x, blockIdx.x);
          EpiRes E{a.x_prompt, (float*)(ws + WS_PRE1)};
          pg8::gemm_phase<EpiRes, pg8::StaticOrder, true, true>(lds, g, S, E); }
        { const pg8::Gemm g = mk_gemm_splitk((const bf16*)(ws + WS_XB) + (size_t)ROW_S * 1024, (const bf16*)(ws + WS_WOUT), 4, 1024, 256, 1024); pg8::StaticOrder S; S.init(4 * 256, 1024, gridDim.x, blockIdx.x);
          EpiPart E{(float*)(ws + WS_PART4)};
          pg8::gemm_phase<EpiPart, pg8::StaticOrder, true, true>(lds, g, S, E); }
    }
    PH_END(4)
    PH_BEGIN(5) { FRESH_ARGS() ln_phase<false>(a, (const float*)(ws + WS_PRE1), a.ln1_g, a.ln1_b, a.x_sample, (const float*)(ws + WS_PART4), 4); } PH_END(5)
    PH_BEGIN(6) { FRESH_ARGS()
        const pg8::Gemm g = mk_gemm((const bf16*)(ws + WS_X1B), (const bf16*)(ws + WS_WGU), MROWS, 2 * DFF, 1024); pg8::StaticOrder S; S.init(MROWS, 2 * DFF, gridDim.x, blockIdx.x);
        EpiGU E{(bf16*)(ws + WS_HBUF)};
        pg8::gemm_phase<EpiGU, pg8::StaticOrder, true, true>(lds, g, S, E);
    }
    PH_END(6)
    PH_BEGIN(7) { FRESH_ARGS()
        { const pg8::Gemm g = mk_gemm((const bf16*)(ws + WS_HBUF), (const bf16*)(ws + WS_WDN), ROW_S, 1024, DFF); pg8::StaticOrder S; S.init(ROW_S, 1024, gridDim.x, blockIdx.x);
          EpiRes E{(const float*)(ws + WS_X1), (float*)(ws + WS_PRE2)};
          pg8::gemm_phase<EpiRes, pg8::StaticOrder, true, true>(lds, g, S, E); }
        { const pg8::Gemm g = mk_gemm_splitk((const bf16*)(ws + WS_HBUF) + (size_t)ROW_S * DFF, (const bf16*)(ws + WS_WDN), 11, 1024, 256, DFF); pg8::StaticOrder S; S.init(11 * 256, 1024, gridDim.x, blockIdx.x);
          EpiPart E{(float*)(ws + WS_PART7)};
          pg8::gemm_phase<EpiPart, pg8::StaticOrder, true, true>(lds, g, S, E); }
    }
    PH_END(7)
    PH_BEGIN(8) { FRESH_ARGS() ln_phase<true>(a, (const float*)(ws + WS_PRE2), a.ln2_g, a.ln2_b, (const float*)(ws + WS_X1) + (size_t)ROW_S * 1024, (const float*)(ws + WS_PART7), 11); } PH_END(8)
#ifdef DBG_STOP
    if (lo <= 9 && 9 < hi) { FRESH_ARGS()
        if (lo == 0) grid.sync();
        const size_t gt = (size_t)blockIdx.x * NTHR + threadIdx.x, nt = (size_t)gridDim.x * NTHR;
#if DBG_STOP == 1
        const bf16* sy = (const bf16*)(ws + WS_PROJ); const bf16* sc = (const bf16*)(ws + WS_PROJ + 8 * SLOT); const bf16* ss = (const bf16*)(ws + WS_PROJ + 10 * SLOT);
        for (size_t i = gt; i < O_PC; i += nt) a.out[i] = bf2f(sy[i]);
        for (size_t i = gt; i < 33554432; i += nt) { a.out[O_SC + i] = bf2f(sc[i]); a.out[O_SS + i] = bf2f(ss[i]); }
        for (size_t i = O_PC + gt; i < O_SC; i += nt) a.out[i] = 0.f;
        for (size_t i = O_SN + gt; i < O_SS; i += nt) a.out[i] = 0.f;
#elif DBG_STOP == 2
        const bf16* sy = (const bf16*)(ws + WS_HA);
        for (size_t i = gt; i < O_PC; i += nt) a.out[i] = bf2f(sy[i]) + bf2f(sy[i + SLOT / 2]);
#elif DBG_STOP == 0
        const bf16* sy = (const bf16*)(ws + WS_XB); const bf16* sc = (const bf16*)(ws + WS_WIN);
        for (size_t i = gt; i < O_PC; i += nt) a.out[i] = bf2f(sy[i]);
        for (size_t i = gt; i < 33554432; i += nt) { a.out[O_SC + i] = i < 10485760 ? bf2f(sc[i]) : 0.f; a.out[O_SS + i] = i < 8 * MROWS ? ((const float*)(ws + WS_G))[i] : 0.f; }
        for (size_t i = O_PC + gt; i < O_SC; i += nt) a.out[i] = 0.f;
        for (size_t i = O_SN + gt; i < O_SS; i += nt) a.out[i] = 0.f;
#endif
    }
#endif
#undef IN
#undef PH_BEGIN
#undef PH_END
}

#ifndef N_LAUNCH_SPLIT
#define N_LAUNCH_SPLIT 0
#endif
extern "C" void kernel_launch(void* const* d_in, const int* in_sizes, int n_in, void* d_out, int out_size, void* d_ws, size_t ws_size, hipStream_t stream) {
    static int grid = 0;
    if (grid == 0) {
        if (n_in != 19 || ws_size < WS_END) { fprintf(stderr, "kernel_launch: need 19 inputs and %zu bytes of workspace; got %d, %zu\n", (size_t)WS_END, n_in, ws_size); grid = -1; return; }
        int dev = 0, cus = 0, per_cu = 0;
        if (hipGetDevice(&dev) != hipSuccess || hipDeviceGetAttribute(&cus, hipDeviceAttributeMultiprocessorCount, dev) != hipSuccess) { grid = -1; return; }
        if (hipFuncSetAttribute((const void*)hybrid_fwd, hipFuncAttributeMaxDynamicSharedMemorySize, LDS_BYTES) != hipSuccess) { fprintf(stderr, "kernel_launch: hipFuncSetAttribute failed\n"); grid = -1; return; }
        if (hipOccupancyMaxActiveBlocksPerMultiprocessor(&per_cu, (const void*)hybrid_fwd, NTHR, LDS_BYTES) != hipSuccess || per_cu < 1) { fprintf(stderr, "kernel_launch: occupancy query says %d blocks per CU\n", per_cu); grid = -1; return; }
        grid = cus;
    }
    if (grid < 0) return;
    Args a{};
    a.x_prompt = (const float*)d_in[0]; a.x_sample = (const float*)d_in[1]; a.st_C = (const float*)d_in[2]; a.st_n = (const float*)d_in[3]; a.st_m = (const float*)d_in[4]; a.st_S = (const float*)d_in[5];
    a.meta = (const float*)d_in[6]; a.w_in = (const float*)d_in[7]; a.b_in = (const float*)d_in[8]; a.ml_g = (const float*)d_in[9]; a.rt_g = (const float*)d_in[10]; a.w_out = (const float*)d_in[11];
    a.ln1_g = (const float*)d_in[12]; a.ln1_b = (const float*)d_in[13]; a.w_gate = (const float*)d_in[14]; a.w_up = (const float*)d_in[15]; a.w_down = (const float*)d_in[16]; a.ln2_g = (const float*)d_in[17]; a.ln2_b = (const float*)d_in[18];
    a.out = (float*)d_out; a.ws = (unsigned char*)d_ws;
#if N_LAUNCH_SPLIT
    for (int p = 0; p < 10; ++p) { a.ph_lo = p; a.ph_hi = p + 1; hipLaunchKernelGGL(hybrid_fwd, dim3(grid), dim3(NTHR), LDS_BYTES, stream, a); }
#else
    a.ph_lo = 0; a.ph_hi = 10;
    void* args[] = {&a};
    hipError_t e = hipLaunchCooperativeKernel((const void*)hybrid_fwd, dim3(grid), dim3(NTHR), args, LDS_BYTES, stream);
    if (e != hipSuccess) fprintf(stderr, "kernel_launch: cooperative launch failed: %s (grid %d)\n", hipGetErrorString(e), grid);
#endif
}
```

```cpp
#include <hip/hip_runtime.h>
#include <hip/hip_cooperative_groups.h>
#include <cstdio>
#include <cstdint>
namespace cg = cooperative_groups;
namespace pg8 {
#define PG8_LAS __attribute__((address_space(3)))
typedef unsigned short bf16_t;
typedef short bf16x8 __attribute__((ext_vector_type(8)));
typedef float f32x4 __attribute__((ext_vector_type(4)));
typedef unsigned u32x4 __attribute__((ext_vector_type(4)));
constexpr int BM = 256, BK = 64, HALF = 128, HTB = HALF * BK * 2  , STAGE_BYTES = 8 * HTB, NXCD = 8, WGM = 8;

__host__ __device__ __forceinline__ int lds_byte(int r, int c) { const int st = (r >> 4) * 2 + (c >> 5), rr = r & 15, cc = c & 31, ob = rr * 64 + cc * 2; return st * 1024 + (ob ^ (((ob >> 9) & 1) << 5)); }
__host__ __device__ __forceinline__ void stage_rc(int b, int& R, int& C) { const int st = b / 1024, sb = b % 1024, swz = sb ^ (((sb >> 9) & 1) << 5); R = (st >> 1) * 16 + swz / 64; C = (st & 1) * 32 + (swz % 64) / 2; }
__host__ __device__ __forceinline__ int perm32(int rho) { const int n = rho >> 4, i = rho & 15; return 8 * (i >> 2) + 4 * n + (i & 3); }

struct Unit { int pm, pn; };
struct Gemm { const bf16_t* A; const bf16_t* Bt; int M, N, K; int ld; size_t a_pm, b_pm, b_pn; };

struct StaticOrder {
    int nM, nN, nwg, G, c;
    __host__ __device__ void init(int M, int N, int G_, int c_) { nM = M / BM; nN = N / BM; nwg = nM * nN; G = G_; c = c_; }
    __host__ __device__ bool next(int i, Unit& u) const {
        const long L = (long)i * G + c; if (L >= nwg) return false;
        int wgid = (int)L; { const int q = nwg / NXCD, r = nwg % NXCD, xcd = wgid % NXCD, off = wgid / NXCD; wgid = (xcd < r ? xcd * (q + 1) : r * (q + 1) + (xcd - r) * q) + off; }
        const int nig = WGM * nN, gid = wgid / nig, fm = gid * WGM, gsz = (nM - fm) < WGM ? (nM - fm) : WGM;
        u.pm = fm + ((wgid % nig) % gsz); u.pn = (wgid % nig) / gsz; return true;
    }
    __device__ __forceinline__ void a_ready(const Unit&) const {}
    __device__ __forceinline__ void done(const Unit&) const {}
};

__device__ __forceinline__ unsigned cvt_pk_bf16(float lo, float hi) { unsigned r; asm volatile("v_cvt_pk_bf16_f32 %0, %1, %2" : "=v"(r) : "v"(lo), "v"(hi)); return r; }
template <class Epi, class Sched, bool ALIGN_EPI = false, bool SP2 = false>
__device__ __forceinline__ void gemm_phase(PG8_LAS unsigned char* lds, const Gemm g, const Sched& S, const Epi& E) {
    const int tid = threadIdx.x, wid = __builtin_amdgcn_readfirstlane(tid >> 6), lane = tid & 63, wr = wid >> 2, wc = wid & 3, fr = lane & 15, fq = lane >> 4;
    const int K = g.K, nt = K / BK;
    unsigned voffA[2], voffB[2];
#pragma unroll
    for (int i = 0; i < 2; ++i) { int R, C; stage_rc(tid * 16 + i * 8192, R, C); const int Rb = Epi::PERM ? ((R & ~31) + perm32(R & 31)) : R;
        voffA[i] = (unsigned)(R * g.ld + C) * 2u; voffB[i] = (unsigned)(Rb * g.ld + C) * 2u; }
    const size_t kstep = (size_t)(BK * 2);
    const size_t hstep = (size_t)HALF * g.ld * 2;
    const size_t tstep = 2 * hstep;
    const unsigned ldsw = (unsigned)wid * 1024u;
    const int aoff = lds_byte(wr * 64 + fr, fq * 8), boff = lds_byte(wc * 32 + fr, fq * 8);
#define PG8_SA(b, h) (((b) * 2 + (h)) * HTB)
#define PG8_SB(b, h) ((4 + (b) * 2 + (h)) * HTB)
#define PG8_STAGE(bufoff, gbase, voff) do { _Pragma("unroll") for (int _i = 0; _i < 2; ++_i) \
        __builtin_amdgcn_global_load_lds((const unsigned*)((const char*)(gbase) + (voff)[_i]), (PG8_LAS unsigned*)(lds + (bufoff) + ldsw + _i * 8192), 16, 0, 0); } while (0)
#define PG8_LDA(dst, b, h) do { _Pragma("unroll") for (int m = 0; m < 4; ++m) _Pragma("unroll") for (int k = 0; k < 2; ++k) dst[m][k] = *(const PG8_LAS bf16x8*)(lds + PG8_SA(b, h) + aoff + m * 2048 + k * 1024); } while (0)
#define PG8_LDB(dst, b, h) do { _Pragma("unroll") for (int n = 0; n < 2; ++n) _Pragma("unroll") for (int k = 0; k < 2; ++k) dst[n][k] = *(const PG8_LAS bf16x8*)(lds + PG8_SB(b, h) + boff + n * 2048 + k * 1024); } while (0)
#define PG8_MMA(ai, bj, At, Bt) do { __builtin_amdgcn_s_setprio(1); _Pragma("unroll") for (int m = 0; m < 4; ++m) _Pragma("unroll") for (int n = 0; n < 2; ++n) _Pragma("unroll") for (int k = 0; k < 2; ++k) \
        acc[ai][bj][m][n] = __builtin_amdgcn_mfma_f32_16x16x32_bf16(Bt[n][k], At[m][k], acc[ai][bj][m][n], 0, 0, 0); __builtin_amdgcn_s_setprio(0); } while (0)
#define PG8_WAIT_V(n) asm volatile("s_waitcnt vmcnt(" #n ")" ::: "memory")
#define PG8_WAIT_L(n) asm volatile("s_waitcnt lgkmcnt(" #n ")" ::: "memory")
#define PG8_BAR __builtin_amdgcn_s_barrier()
#define PG8_SCHED __builtin_amdgcn_sched_barrier(0)
    Unit cur, nxt; int ui = 0;
    if (!S.next(0, cur)) return;
    f32x4 acc[2][2][4][2];
#pragma unroll
    for (int a = 0; a < 2; ++a)
#pragma unroll
        for (int b = 0; b < 2; ++b)
#pragma unroll
            for (int m = 0; m < 4; ++m)
#pragma unroll
                for (int n = 0; n < 2; ++n) acc[a][b][m][n] = (f32x4){0.f, 0.f, 0.f, 0.f};
    bf16x8 At[4][2], B0[2][2], B1[2][2];
    const char* cA = (const char*)g.A + (size_t)cur.pm * g.a_pm; const char* cB = (const char*)g.Bt + (size_t)cur.pm * g.b_pm + (size_t)cur.pn * g.b_pn;
    S.a_ready(cur);
    if constexpr (SP2) {
        PG8_STAGE(PG8_SB(0, 0), cB, voffB); PG8_STAGE(PG8_SB(0, 1), cB + hstep, voffB); PG8_STAGE(PG8_SA(0, 0), cA, voffA); PG8_STAGE(PG8_SA(0, 1), cA + hstep, voffA);
        if (wr == 1) PG8_BAR;
        PG8_WAIT_V(2); PG8_BAR;
        PG8_STAGE(PG8_SB(1, 0), cB + kstep, voffB); PG8_STAGE(PG8_SA(1, 0), cA + kstep, voffA); PG8_STAGE(PG8_SB(1, 1), cB + hstep + kstep, voffB);
        PG8_WAIT_V(6); PG8_BAR;
    } else {
        PG8_STAGE(PG8_SB(0, 0), cB, voffB); PG8_STAGE(PG8_SA(0, 0), cA, voffA); PG8_STAGE(PG8_SB(0, 1), cB + hstep, voffB); PG8_STAGE(PG8_SA(0, 1), cA + hstep, voffA);
        if (wr == 1) PG8_BAR;
        PG8_WAIT_V(4); PG8_BAR;
        PG8_STAGE(PG8_SB(1, 0), cB + kstep, voffB); PG8_STAGE(PG8_SA(1, 0), cA + kstep, voffA); PG8_STAGE(PG8_SB(1, 1), cB + hstep + kstep, voffB);
        PG8_WAIT_V(6); PG8_BAR;
    }
    for (;;) {
        const bool has_next = S.next(ui + 1, nxt);
        const char* nA = has_next ? (const char*)g.A + (size_t)nxt.pm * g.a_pm : cA; const char* nB = has_next ? (const char*)g.Bt + (size_t)nxt.pm * g.b_pm + (size_t)nxt.pn * g.b_pn : cB;
        for (int t = 0; t < nt; t += 2) {
            const bool last = (t == nt - 2);
            const char* a1 = cA + (size_t)(t + 1) * kstep;
            const char* a2 = last ? nA : cA + (size_t)(t + 2) * kstep; const char* b2 = last ? nB : cB + (size_t)(t + 2) * kstep;
            const char* a3 = a2 + kstep; const char* b3 = b2 + kstep;
            if (last && has_next) S.a_ready(nxt);
            if constexpr (SP2) {
            PG8_LDB(B0, 0, 0); PG8_LDB(B1, 0, 1); PG8_SCHED; PG8_LDA(At, 0, 0); PG8_STAGE(PG8_SA(1, 1), a1 + hstep, voffA);
            PG8_WAIT_V(8); PG8_WAIT_L(0); PG8_BAR; PG8_MMA(0, 0, At, B0); PG8_MMA(0, 1, At, B1); PG8_BAR; PG8_SCHED;
            PG8_LDA(At, 0, 1); PG8_STAGE(PG8_SB(0, 0), b2, voffB); PG8_STAGE(PG8_SB(0, 1), b2 + hstep, voffB); PG8_STAGE(PG8_SA(0, 0), a2, voffA);
            PG8_WAIT_V(8); PG8_WAIT_L(0); PG8_BAR; PG8_MMA(1, 0, At, B0); PG8_MMA(1, 1, At, B1); PG8_BAR; PG8_SCHED;
            PG8_LDB(B0, 1, 0); PG8_LDB(B1, 1, 1); PG8_SCHED; PG8_LDA(At, 1, 0); PG8_STAGE(PG8_SA(0, 1), a2 + hstep, voffA);
            PG8_WAIT_V(8); PG8_WAIT_L(0); PG8_BAR; PG8_MMA(0, 0, At, B0); PG8_MMA(0, 1, At, B1); PG8_BAR; PG8_SCHED;
            PG8_LDA(At, 1, 1); PG8_STAGE(PG8_SB(1, 0), b3, voffB); PG8_STAGE(PG8_SB(1, 1), b3 + hstep, voffB); PG8_STAGE(PG8_SA(1, 0), a3, voffA);
            PG8_WAIT_V(8); PG8_WAIT_L(0); PG8_BAR; PG8_MMA(1, 0, At, B0); PG8_MMA(1, 1, At, B1); PG8_BAR; PG8_SCHED;
            } else {
            PG8_LDB(B0, 0, 0); PG8_SCHED; PG8_LDA(At, 0, 0); PG8_STAGE(PG8_SA(1, 1), a1 + hstep, voffA);
            PG8_WAIT_L(8); PG8_BAR; PG8_WAIT_L(0); PG8_MMA(0, 0, At, B0); PG8_BAR; PG8_SCHED;
            PG8_LDB(B1, 0, 1); PG8_STAGE(PG8_SB(0, 0), b2, voffB);
            PG8_BAR; PG8_WAIT_L(0); PG8_MMA(0, 1, At, B1); PG8_BAR;
            PG8_LDA(At, 0, 1); PG8_STAGE(PG8_SA(0, 0), a2, voffA);
            PG8_BAR; PG8_WAIT_L(0); PG8_MMA(1, 0, At, B0); PG8_BAR; PG8_SCHED;
            PG8_STAGE(PG8_SB(0, 1), b2 + hstep, voffB);
            PG8_WAIT_V(6); PG8_BAR; PG8_MMA(1, 1, At, B1); PG8_BAR;
            PG8_LDB(B0, 1, 0); PG8_SCHED; PG8_LDA(At, 1, 0); PG8_STAGE(PG8_SA(0, 1), a2 + hstep, voffA);
            PG8_WAIT_L(8); PG8_BAR; PG8_WAIT_L(0); PG8_MMA(0, 0, At, B0); PG8_BAR; PG8_SCHED;
            PG8_LDB(B1, 1, 1); PG8_STAGE(PG8_SB(1, 0), b3, voffB);
            PG8_BAR; PG8_WAIT_L(0); PG8_MMA(0, 1, At, B1); PG8_BAR;
            PG8_LDA(At, 1, 1); PG8_STAGE(PG8_SA(1, 0), a3, voffA);
            PG8_BAR; PG8_WAIT_L(0); PG8_MMA(1, 0, At, B0); PG8_BAR; PG8_SCHED;
            PG8_STAGE(PG8_SB(1, 1), b3 + hstep, voffB);
            PG8_WAIT_V(6); PG8_BAR; PG8_MMA(1, 1, At, B1); PG8_BAR;
            }
        }
        if constexpr (ALIGN_EPI) { if (wr == 0) PG8_BAR; }
        if constexpr (!Epi::AFTER_DRAIN) { E(acc, cur, wr, wc, fr, fq); S.done(cur); }
        if (!has_next) break;
#pragma unroll
        for (int a = 0; a < 2; ++a)
#pragma unroll
            for (int b = 0; b < 2; ++b)
#pragma unroll
                for (int m = 0; m < 4; ++m)
#pragma unroll
                    for (int n = 0; n < 2; ++n) acc[a][b][m][n] = (f32x4){0.f, 0.f, 0.f, 0.f};
        cur = nxt; cA = nA; cB = nB; ++ui;
        if constexpr (ALIGN_EPI) { if (wr == 1) PG8_BAR; }
    }
    PG8_WAIT_V(0);
    if constexpr (!ALIGN_EPI) { if (wr == 0) PG8_BAR; }
    PG8_BAR;
    if constexpr (Epi::AFTER_DRAIN) { E.fused(acc, cur, wr, wc, fr, fq, lds, wid, lane); S.done(cur); }
#undef PG8_SA
#undef PG8_SB
#undef PG8_STAGE
#undef PG8_LDA
#undef PG8_LDB
#undef PG8_MMA
#undef PG8_WAIT_V
#undef PG8_WAIT_L
#undef PG8_BAR
#undef PG8_SCHED
}
}

#define LAS __attribute__((address_space(3)))
typedef unsigned short bf16;
typedef float f32x4 __attribute__((ext_vector_type(4)));
typedef short bf16x8 __attribute__((ext_vector_type(8)));
typedef unsigned u32x4 __attribute__((ext_vector_type(4)));
typedef unsigned u32x2 __attribute__((ext_vector_type(2)));

constexpr int NTHR = 512;
constexpr int DM = 1024, NB = 8, SEQ = 2048, NMETA = 16, DEC = 128, NH = 4, HD = 256, DFF = 2816, NCOL_SRC = 10248;
constexpr int MROWS = 16640;
constexpr int ROW_S = 16384, ROW_M = 16512, ROW_V = 16512  ;
constexpr int NPOS = 2065;
constexpr int SCN = 2065;
constexpr float LN_EPS = 1e-5f;
constexpr float ALPHA = 1.189207115002721f;

constexpr size_t MiB = 1u << 20;
constexpr size_t SLOT = (size_t)MROWS * 1024 * 2;
constexpr size_t WS_WIN = 0;
constexpr size_t WS_HA = 0, WS_HB = SLOT;
constexpr size_t WS_XB = 65 * MiB;
constexpr size_t WS_WOUT = WS_XB + SLOT;
constexpr size_t WS_WGU = WS_WOUT + 2 * MiB;
constexpr size_t WS_WDN = WS_WGU + 11 * MiB;
constexpr size_t WS_G = 116 * MiB;
constexpr size_t WS_ROT = 117 * MiB;
constexpr size_t WS_SF = 119 * MiB + 256 * 1024, WS_SM = 119 * MiB + 640 * 1024;
static_assert(WS_ROT + (size_t)NPOS * 128 * 8 <= WS_SF && WS_SF + 32 * SCN * 4 <= WS_SM && WS_SM + 32 * SCN * 4 <= 120 * MiB, "ws map (scan arrays)");
constexpr size_t WS_CTL = 119 * MiB + 960 * 1024, CTL_BYTES = 16384;
constexpr size_t WS_PROJ = 120 * MiB;
constexpr size_t WS_END = WS_PROJ + 12 * SLOT;
constexpr size_t WS_PRE1 = WS_PROJ, WS_X1 = WS_PROJ + 65 * MiB, WS_X1B = WS_PROJ + 130 * MiB, WS_HBUF = WS_PROJ + 163 * MiB, WS_PRE2 = WS_PROJ + 253 * MiB, WS_PART4 = WS_PROJ + 320 * MiB, WS_PART7 = WS_PROJ + 328 * MiB;
static_assert(WS_WDN + (size_t)DM * DFF * 2 <= WS_G && WS_HBUF + (size_t)MROWS * DFF * 2 <= WS_PRE2 && WS_PRE2 + 65 * MiB <= WS_END, "ws map");

constexpr int LDS_BYTES = 155648;
constexpr int KOFF = 0, COFF = 65536, VOFF = COFF + 40960, VBUF = 20480, AOFF = VOFF + 2 * VBUF, ABUF = 2560;
static_assert(AOFF + 2 * ABUF <= LDS_BYTES, "mixer LDS map");

constexpr size_t O_YP = 0, O_YS = 16777216, O_PC = O_YS + 131072, O_PN = O_PC + 2097152, O_PM = O_PN + 8192, O_PS = O_PM + 32,
                 O_SC = O_PS + 2097152, O_SN = O_SC + 33554432, O_SM = O_SN + 131072, O_SS = O_SM + 512;

__device__ __forceinline__ unsigned f2bf(float f) { unsigned u = __builtin_bit_cast(unsigned, f); return (u + 0x7fffu + ((u >> 16) & 1u)) >> 16; }
__device__ __forceinline__ unsigned pk2(float lo, float hi) { return f2bf(lo) | (f2bf(hi) << 16); }
__device__ __forceinline__ float bf2f(unsigned h) { return __builtin_bit_cast(float, h << 16); }
__device__ __forceinline__ float wave_sum(float v) {
#pragma unroll
    for (int o = 1; o < 64; o <<= 1) v += __shfl_xor(v, o);
    return v;
}
__device__ __forceinline__ float sigmoidf_(float x) { return 1.f / (1.f + __expf(-x)); }
__device__ __forceinline__ float logsigf_(float x) { return fminf(x, 0.f) - log1pf(expf(-fabsf(x))); }
__device__ __forceinline__ int opaque_tid() { int t = threadIdx.x; asm volatile("" : "+v"(t)); return t; }
__device__ __forceinline__ int posidx(int row) { return row < ROW_S ? (row & 2047) + 16 : (row < ROW_M ? 2064 : (row < ROW_M + 16 ? row - ROW_M : 0)); }

struct Args {
    const float *x_prompt, *x_sample, *st_C, *st_n, *st_m, *st_S, *meta, *w_in, *b_in, *ml_g, *rt_g, *w_out, *ln1_g, *ln1_b, *w_gate, *w_up, *w_down, *ln2_g, *ln2_b;
    float* out; unsigned char* ws; int ph_lo, ph_hi;
};

__device__ __forceinline__ pg8::Gemm mk_gemm(const bf16* A, const bf16* Bt, int M, int N, int K) { return pg8::Gemm{A, Bt, M, N, K, K, (size_t)512 * K, 0, (size_t)512 * K}; }
__device__ __forceinline__ pg8::Gemm mk_gemm_splitk(const bf16* A, const bf16* Bt, int nsplit, int N, int KS, int ld) { return pg8::Gemm{A, Bt, nsplit * 256, N, KS, ld, (size_t)2 * KS, (size_t)2 * KS, (size_t)512 * ld}; }
struct EpiProj {
    static constexpr bool PERM = false, AFTER_DRAIN = false;
    unsigned char* ws; const float* b_in;
    __device__ __forceinline__ void operator()(const f32x4 (&acc)[2][2][4][2], const pg8::Unit& u, int wr, int wc, int fr, int fq) const {
        const int grp = u.pn >> 2, head = u.pn & 3;
        const int rmslot = grp == 0 ? 0 : grp == 1 ? 1 : grp == 3 ? 2 : grp == 4 ? 3 : grp == 5 ? 4 : grp == 7 ? 5 : grp == 8 ? 6 : grp == 9 ? 7 : -1;
        const int tslot = grp == 1 ? 8 : grp == 2 ? 9 : grp == 5 ? 10 : grp == 6 ? 11 : -1;
        const bool rot = (grp == 4 || grp == 5);
        const int act = (grp == 3 || grp >= 8) ? 1 : (grp == 7 ? 2 : 0);
        const float bsc = (grp == 1 || grp == 5) ? 0.0625f : 1.f;
        const int colh = wc * 32 + 4 * fq;
        const float* bsrc = b_in + grp * 1024 + head * 256 + (grp >= 4 ? 8 : 0) + colh;
        f32x4 bv[2][2];
#pragma unroll
        for (int bj = 0; bj < 2; ++bj)
#pragma unroll
            for (int n = 0; n < 2; ++n) bv[bj][n] = *(const f32x4*)(bsrc + bj * 128 + n * 16) * bsc;
        bf16* rm = rmslot >= 0 ? (bf16*)(ws + WS_PROJ + (size_t)rmslot * SLOT) : nullptr;
        bf16* tb = tslot >= 0 ? (bf16*)(ws + WS_PROJ + (size_t)tslot * SLOT) : nullptr;
        const float* rotp = (const float*)(ws + WS_ROT);
#pragma unroll
        for (int ai = 0; ai < 2; ++ai)
#pragma unroll
            for (int m = 0; m < 4; ++m) {
                const int row = u.pm * 256 + ai * 128 + wr * 64 + m * 16 + fr;
                f32x4 v[2][2];
#pragma unroll
                for (int bj = 0; bj < 2; ++bj)
#pragma unroll
                    for (int n = 0; n < 2; ++n) v[bj][n] = acc[ai][bj][m][n] + bv[bj][n];
                if (rot) {
                    const float* cs = rotp + ((size_t)posidx(row) * 128 + colh) * 2;
#pragma unroll
                    for (int n = 0; n < 2; ++n) {
                        const f32x4 c0 = *(const f32x4*)(cs + n * 32), c1 = *(const f32x4*)(cs + n * 32 + 4);
                        const f32x4 x1 = v[0][n], x2 = v[1][n];
                        v[0][n] = (f32x4){x1[0] * c0[0] - x2[0] * c0[1], x1[1] * c0[2] - x2[1] * c0[3], x1[2] * c1[0] - x2[2] * c1[1], x1[3] * c1[2] - x2[3] * c1[3]};
                        v[1][n] = (f32x4){x1[0] * c0[1] + x2[0] * c0[0], x1[1] * c0[3] + x2[1] * c0[2], x1[2] * c1[1] + x2[2] * c1[0], x1[3] * c1[3] + x2[3] * c1[2]};
                    }
                }
                if (act == 1) {
#pragma unroll
                    for (int bj = 0; bj < 2; ++bj)
#pragma unroll
                        for (int n = 0; n < 2; ++n)
#pragma unroll
                            for (int i = 0; i < 4; ++i) v[bj][n][i] = sigmoidf_(v[bj][n][i]);
                } else if (act == 2) {
#pragma unroll
                    for (int bj = 0; bj < 2; ++bj)
#pragma unroll
                        for (int n = 0; n < 2; ++n)
#pragma unroll
                            for (int i = 0; i < 4; ++i) v[bj][n][i] = v[bj][n][i] * sigmoidf_(v[bj][n][i]);
                }
                if (rm) {
                    bf16* rp = rm + (size_t)row * 1024 + head * 256 + colh;
#pragma unroll
                    for (int bj = 0; bj < 2; ++bj)
#pragma unroll
                        for (int n = 0; n < 2; ++n) { u32x2 w; w.x = pk2(v[bj][n][0], v[bj][n][1]); w.y = pk2(v[bj][n][2], v[bj][n][3]); *(u32x2*)(rp + bj * 128 + n * 16) = w; }
                }
#ifndef OPT_DPP
#define OPT_DPP 1
#endif
#if OPT_DPP
                if (tb) {
                    const int qb = fr & 3; const bool odd = qb & 1, hi2 = qb & 2;
                    bf16* tp = tb + (size_t)(head * 256 + colh + qb) * MROWS + (row - qb);
#pragma unroll
                    for (int bj = 0; bj < 2; ++bj)
#pragma unroll
                        for (int n = 0; n < 2; ++n) {
                            const float f0_ = v[bj][n][0], f1_ = v[bj][n][1], f2_ = v[bj][n][2], f3_ = v[bj][n][3];
                            int x0 = __float_as_int(f0_), x1 = __float_as_int(f1_), x2 = __float_as_int(f2_), x3 = __float_as_int(f3_);
                            int a0, a1, a2, a3, b0, b1, b2, b3;
#define DPPX1(d, s_) asm volatile("s_nop 1\n\tv_mov_b32_dpp %0, %1 quad_perm:[1,0,3,2] row_mask:0xf bank_mask:0xf bound_ctrl:1" : "=&v"(d) : "v"(s_))
#define DPPX2(d, s_) asm volatile("s_nop 1\n\tv_mov_b32_dpp %0, %1 quad_perm:[2,3,0,1] row_mask:0xf bank_mask:0xf bound_ctrl:1" : "=&v"(d) : "v"(s_))
                            DPPX1(a0, x0); DPPX1(a1, x1); DPPX1(a2, x2); DPPX1(a3, x3);
                            x0 = odd ? a1 : x0; x1 = odd ? x1 : a0; x2 = odd ? a3 : x2; x3 = odd ? x3 : a2;
                            DPPX2(b0, x0); DPPX2(b1, x1); DPPX2(b2, x2); DPPX2(b3, x3);
                            if (hi2) { x0 = b2; x1 = b3; } else { x2 = b0; x3 = b1; }
#undef DPPX1
#undef DPPX2
                            u32x2 w; w.x = pk2(__int_as_float(x0), __int_as_float(x1)); w.y = pk2(__int_as_float(x2), __int_as_float(x3));
                            *(u32x2*)(tp + (size_t)(bj * 128 + n * 16) * MROWS) = w;
                        }
                }
#else
                if (tb) {
                    bf16* tp = tb + (size_t)(head * 256 + colh) * MROWS + row;
#pragma unroll
                    for (int bj = 0; bj < 2; ++bj)
#pragma unroll
                        for (int n = 0; n < 2; ++n)
#pragma unroll
                            for (int i = 0; i < 4; ++i) tp[(size_t)(bj * 128 + n * 16 + i) * MROWS] = (bf16)f2bf(v[bj][n][i]);
                }
#endif
            }
    }
};
struct EpiRes {
    static constexpr bool PERM = false, AFTER_DRAIN = false;
    const float* base; float* out;
    __device__ __forceinline__ void operator()(const f32x4 (&acc)[2][2][4][2], const pg8::Unit& u, int wr, int wc, int fr, int fq) const {
        const int col0 = u.pn * 256 + wc * 32 + 4 * fq;
#pragma unroll
        for (int ai = 0; ai < 2; ++ai)
#pragma unroll
            for (int m = 0; m < 4; ++m) {
                const int row = u.pm * 256 + ai * 128 + wr * 64 + m * 16 + fr;
                const float* bp = base + (size_t)row * 1024 + col0;
                float* op = out + (size_t)row * 1024 + col0;
#pragma unroll
                for (int bj = 0; bj < 2; ++bj)
#pragma unroll
                    for (int n = 0; n < 2; ++n) { const f32x4 x = *(const f32x4*)(bp + bj * 128 + n * 16); *(f32x4*)(op + bj * 128 + n * 16) = x * ALPHA + acc[ai][bj][m][n]; }
            }
    }
};
struct EpiPart {
    static constexpr bool PERM = false, AFTER_DRAIN = false;
    float* part;
    __device__ __forceinline__ void operator()(const f32x4 (&acc)[2][2][4][2], const pg8::Unit& u, int wr, int wc, int fr, int fq) const {
        const int col0 = u.pn * 256 + wc * 32 + 4 * fq;
#pragma unroll
        for (int m = 0; m < 4; ++m) {
            const int r = wr * 64 + m * 16 + fr;
            float* op = part + ((size_t)u.pm * 128 + r) * 1024 + col0;
#pragma unroll
            for (int bj = 0; bj < 2; ++bj)
#pragma unroll
                for (int n = 0; n < 2; ++n) *(f32x4*)(op + bj * 128 + n * 16) = acc[0][bj][m][n];
        }
    }
};
struct EpiGU {
    static constexpr bool PERM = false, AFTER_DRAIN = false;
    bf16* hb;
    __device__ __forceinline__ void operator()(const f32x4 (&acc)[2][2][4][2], const pg8::Unit& u, int wr, int wc, int fr, int fq) const {
        const int col0 = u.pn * 128 + wc * 32 + 4 * fq;
#pragma unroll
        for (int ai = 0; ai < 2; ++ai)
#pragma unroll
            for (int m = 0; m < 4; ++m) {
                const int row = u.pm * 256 + ai * 128 + wr * 64 + m * 16 + fr;
                bf16* op = hb + (size_t)row * DFF + col0;
#pragma unroll
                for (int n = 0; n < 2; ++n) {
                    const f32x4 g = acc[ai][0][m][n], up = acc[ai][1][m][n]; float r[4];
#pragma unroll
                    for (int i = 0; i < 4; ++i) r[i] = g[i] * sigmoidf_(g[i]) * up[i];
                    u32x2 w; w.x = pk2(r[0], r[1]); w.y = pk2(r[2], r[3]); *(u32x2*)(op + n * 16) = w;
                }
            }
    }
};

__device__ __forceinline__ void transpose_item(const float* W, int ldw, int sc0, int k0, bf16* WT, int ldk, int dr0, float scale, LAS float* scr, int lane) {
#pragma unroll 8
    for (int i = 0; i < 32; ++i) { const int kk = 2 * i + (lane >> 5); scr[kk * 33 + (lane & 31)] = W[(size_t)(k0 + kk) * ldw + sc0 + (lane & 31)] * scale; }
    asm volatile("s_waitcnt lgkmcnt(0)" ::: "memory");
    const int c = lane & 7;
#pragma unroll
    for (int j = 0; j < 4; ++j) { const int n = (lane >> 3) + 8 * j; const LAS float* s = scr + (8 * c) * 33 + n;
        u32x4 o; o.x = pk2(s[0 * 33], s[1 * 33]); o.y = pk2(s[2 * 33], s[3 * 33]); o.z = pk2(s[4 * 33], s[5 * 33]); o.w = pk2(s[6 * 33], s[7 * 33]);
        *(u32x4*)(WT + (size_t)(dr0 + n) * ldk + k0 + 8 * c) = o; }
    asm volatile("s_waitcnt lgkmcnt(0)" ::: "memory");
}

__device__ __forceinline__ void p0_prologue(const Args& a, LAS unsigned char* lds) {
    const int tid = opaque_tid(), lane = tid & 63, wave = __builtin_amdgcn_readfirstlane(tid >> 6);
    const int gw = blockIdx.x * 8 + wave, NGW = gridDim.x * 8;
    unsigned char* ws = a.ws;
    LAS float* scr = (LAS float*)(lds + wave * 8704);
    LAS float* wgt = (LAS float*)(lds + 69632);
    for (int idx = tid; idx < 8192; idx += NTHR) { const int k = idx >> 3, c = idx & 7; wgt[c * 1024 + k] = a.w_in[(size_t)k * NCOL_SRC + 4096 + c]; }
    constexpr int I_IN = 16 * 320, I_OUT = 16 * 32, I_G = 16 * 88, I_D = 44 * 32;
    constexpr int NITEMS = I_IN + I_OUT + 2 * I_G + I_D;
    for (int it = gw; it < NITEMS; it += NGW) {
        int r = it;
        if (r < I_IN) { const int kb = r / 320, nb = r % 320; const float sc = ((nb >= 32 && nb < 64) || (nb >= 160 && nb < 192)) ? 0.0625f : 1.f;
            transpose_item(a.w_in, NCOL_SRC, 32 * nb + (nb >= 128 ? 8 : 0), 64 * kb, (bf16*)(ws + WS_WIN), 1024, 32 * nb, sc, scr, lane); continue; } r -= I_IN;
        if (r < I_OUT) { const int kb = r / 32, nb = r % 32; transpose_item(a.w_out, 1024, 32 * nb, 64 * kb, (bf16*)(ws + WS_WOUT), 1024, 32 * nb, 1.f, scr, lane); continue; } r -= I_OUT;
        if (r < I_G) { const int kb = r / 88, nb = r % 88; transpose_item(a.w_gate, DFF, 32 * nb, 64 * kb, (bf16*)(ws + WS_WGU), 1024, 256 * (nb >> 2) + 32 * (nb & 3), 1.f, scr, lane); continue; } r -= I_G;
        if (r < I_G) { const int kb = r / 88, nb = r % 88; transpose_item(a.w_up, DFF, 32 * nb, 64 * kb, (bf16*)(ws + WS_WGU), 1024, 256 * (nb >> 2) + 128 + 32 * (nb & 3), 1.f, scr, lane); continue; } r -= I_G;
        { const int kb = r / 32, nb = r % 32; transpose_item(a.w_down, 1024, 32 * nb, 64 * kb, (bf16*)(ws + WS_WDN), DFF, 32 * nb, 1.f, scr, lane); }
    }
    __syncthreads();
    bf16* XB = (bf16*)(ws + WS_XB); float* G = (float*)(ws + WS_G);
    for (int row = gw; row < MROWS; row += NGW) {
        const float* src = row < ROW_S ? a.x_prompt + (size_t)row * 1024 : (row < ROW_M ? a.x_sample + (size_t)(row - ROW_S) * 1024 : (row < ROW_M + 16 ? a.meta + (size_t)(row - ROW_M) * 1024 : nullptr));
        f32x4 v[4];
#pragma unroll
        for (int j = 0; j < 4; ++j) v[j] = src ? ((const f32x4*)src)[lane + 64 * j] : (f32x4){0.f, 0.f, 0.f, 0.f};
#pragma unroll
        for (int j = 0; j < 4; ++j) { u32x2 w; w.x = pk2(v[j][0], v[j][1]); w.y = pk2(v[j][2], v[j][3]); ((u32x2*)(XB + (size_t)row * 1024))[lane + 64 * j] = w; }
        float mine = 0.f;
#pragma unroll
        for (int c = 0; c < 8; ++c) {
            float d = 0.f;
#pragma unroll
            for (int j = 0; j < 4; ++j) { const f32x4 wv = ((const LAS f32x4*)(wgt + c * 1024))[lane + 64 * j]; d += v[j][0] * wv[0] + v[j][1] * wv[1] + v[j][2] * wv[2] + v[j][3] * wv[3]; }
            d = wave_sum(d);
            if (lane == c) mine = d;
        }
        if (lane < 8) G[(size_t)row * 8 + lane] = mine + a.b_in[4096 + lane];
    }
    float* rot = (float*)(ws + WS_ROT);
    for (int e = blockIdx.x * NTHR + tid; e < NPOS * 128; e += gridDim.x * NTHR) {
        const int p = e >> 7, j = e & 127;
        double inv = 1.0, rr = 0.930572040929699;
#pragma unroll
        for (int bit = 0; bit < 7; ++bit) { if ((j >> bit) & 1) inv *= rr; rr *= rr; }
        const double pos = (p == 2064) ? 16384.0 : (double)p;
        const double t = pos * inv * 0.15915494309189535; const double fr = t - floor(t);
        const float f = (float)fr;
        rot[2 * e] = __builtin_amdgcn_cosf(f); rot[2 * e + 1] = __builtin_amdgcn_sinf(f);
    }
}

__device__ __forceinline__ void gate_scan(const Args& a, LAS unsigned char* lds, int bh) {
    const int tid = opaque_tid(), b = bh >> 2, h = bh & 3;
    const float* G = (const float*)(a.ws + WS_G);
    float* SF = (float*)(a.ws + WS_SF) + (size_t)bh * SCN; float* SM = (float*)(a.ws + WS_SM) + (size_t)bh * SCN;
    float F = 0.f, M = 0.f;
    if (tid == 0) { SF[0] = 0.f; SM[0] = 0.f; }
    for (int s = 0; s < NMETA; ++s) { const float gi = G[(size_t)(ROW_M + s) * 8 + h], gf = logsigf_(G[(size_t)(ROW_M + s) * 8 + 4 + h]); F += gf; M = fmaxf(M + gf, gi); if (tid == 0) { SF[s + 1] = F; SM[s + 1] = M; } }
    const int row = b * 2048 + 4 * tid;
    float f[4], gi[4], pa = 0.f, pc = -INFINITY;
#pragma unroll
    for (int k = 0; k < 4; ++k) { gi[k] = G[(size_t)(row + k) * 8 + h]; f[k] = logsigf_(G[(size_t)(row + k) * 8 + 4 + h]); pc = fmaxf(pc + f[k], gi[k]); pa += f[k]; }
    LAS float* sa = (LAS float*)lds; LAS float* sc = sa + 512;
    for (int off = 1; off < 512; off <<= 1) {
        sa[tid] = pa; sc[tid] = pc; __syncthreads();
        float la = 0.f, lc = -INFINITY; const bool has = tid >= off;
        if (has) { la = sa[tid - off]; lc = sc[tid - off]; }
        __syncthreads();
        if (has) { pc = fmaxf(lc + pa, pc); pa = la + pa; }
    }
    sa[tid] = pa; sc[tid] = pc; __syncthreads();
    float ea = 0.f, ec = -INFINITY; if (tid > 0) { ea = sa[tid - 1]; ec = sc[tid - 1]; }
    __syncthreads();
    float Fb = F + ea, Mb = fmaxf(M + ea, ec);
#pragma unroll
    for (int k = 0; k < 4; ++k) { Fb += f[k]; Mb = fmaxf(Mb + f[k], gi[k]); SF[17 + 4 * tid + k] = Fb; SM[17 + 4 * tid + k] = Mb; }
}

__device__ __forceinline__ f32x4 mfma16(bf16x8 x, bf16x8 y, f32x4 c) { return __builtin_amdgcn_mfma_f32_16x16x32_bf16(x, y, c, 0, 0, 0); }

template <bool ML>
__device__ __forceinline__ void mixer_unit(const Args& a, LAS unsigned char* lds, int b, int h, int slice) {
    constexpr int NDB = ML ? 5 : 4;
    int tid_ = threadIdx.x; asm volatile("" : "+v"(tid_));
    const int tid = tid_, w = __builtin_amdgcn_readfirstlane(tid >> 6), lane = tid & 63, fr = lane & 15, fq = lane >> 4;
    unsigned char* ws = a.ws;
    const bf16* Q = (const bf16*)(ws + WS_PROJ + (size_t)(ML ? 0 : 3) * SLOT);
    const bf16* Kr = (const bf16*)(ws + WS_PROJ + (size_t)(ML ? 1 : 4) * SLOT);
    const bf16* KT = (const bf16*)(ws + WS_PROJ + (size_t)(ML ? 8 : 10) * SLOT);
    const bf16* VT = (const bf16*)(ws + WS_PROJ + (size_t)(ML ? 9 : 11) * SLOT);
    bf16* Hout = (bf16*)(ws + (ML ? WS_HA : WS_HB));
    const float* G = (const float*)(ws + WS_G);
    const int bh = b * 4 + h;
    const float* SF = (const float*)(ws + WS_SF) + (size_t)bh * SCN; const float* SM = (const float*)(ws + WS_SM) + (size_t)bh * SCN;
    const float lg = log1pf(-exp2f(-5.f - (float)h));
    const int tb = w < 4 ? w : 11 - w;
    const int swz = ((fr >> 3) & 1) << 5;
    const int boff = (fr * 64 + fq * 16) ^ swz;
    const int vof0 = (fr * 64 + fq * 8) ^ swz, vof1 = (fr * 64 + 32 + fq * 8) ^ swz;
    const bf16* KTb = KT + (size_t)(h * 256 + w * 32 + fr) * MROWS + 4 * fq;
    const bf16* VTb = VT + (size_t)(h * 256 + slice * 64) * MROWS;
    int kR[2], kC[2];
#pragma unroll
    for (int i = 0; i < 2; ++i) pg8::stage_rc(tid * 16 + i * 8192, kR[i], kC[i]);
    const bf16* Ksrc0 = Kr + (size_t)kR[0] * 1024 + h * 256 + kC[0]; const bf16* Ksrc1 = Kr + (size_t)kR[1] * 1024 + h * 256 + kC[1];
    int vsrc[2];
#pragma unroll
    for (int j = 0; j < 2; ++j) { const int idx = 2 * w + j, t = idx >> 3, st = idx & 7; const int p = 16 * lane, ob = p ^ (((p >> 9) & 1) << 5), rr = ob >> 6, cc = (ob & 63) >> 1;
        vsrc[j] = ((st >> 1) * 16 + rr) * MROWS + t * 64 + (st & 1) * 32 + cc; }
#define MIX_DMA_TO(c_, buf_) do { const int r0n_ = b * 2048 + 128 * (c_); \
        _Pragma("unroll") for (int kt = 0; kt < 4; ++kt) { \
            __builtin_amdgcn_global_load_lds((const unsigned*)(Ksrc0 + (size_t)r0n_ * 1024 + kt * 64), (LAS unsigned*)(lds + KOFF + kt * 16384 + w * 1024), 16, 0, 0); \
            __builtin_amdgcn_global_load_lds((const unsigned*)(Ksrc1 + (size_t)r0n_ * 1024 + kt * 64), (LAS unsigned*)(lds + KOFF + kt * 16384 + w * 1024 + 8192), 16, 0, 0); } \
        _Pragma("unroll") for (int j = 0; j < 2; ++j) { const int idx = 2 * w + j; \
            __builtin_amdgcn_global_load_lds((const unsigned*)(VTb + vsrc[j] + r0n_), (LAS unsigned*)(lds + VOFF + (buf_) * VBUF + (idx >> 3) * 10240 + (idx & 7) * 1024), 16, 0, 0); } \
    } while (0)
#define MIX_DMA(c_) MIX_DMA_TO(c_, (c_) & 1)
#define MIX_ARRAYS_TO(c_, buf_) do { LAS float* ar_ = (LAS float*)(lds + AOFF + (buf_) * ABUF); const int t0n_ = 16 + 128 * (c_), tj_ = tid & 127; \
        if (ML) { const float Fp = SF[t0n_], Mp = SM[t0n_], Fe = SF[t0n_ + 128], Me = SM[t0n_ + 128]; \
            const float Fj = SF[t0n_ + 1 + tj_], Mj = SM[t0n_ + 1 + tj_], gi = G[(size_t)(b * 2048 + 128 * (c_) + tj_) * 8 + h]; \
            const float v0_ = Fj - Mj, v1_ = gi - Fj, v2_ = __expf(Fj - Fp + Mp - Mj), v3_ = __expf(Fe - Fj + gi - Me), v4_ = __expf(-Mj); \
            if (tid < 128) { ar_[tid] = v0_; ar_[128 + tid] = v1_; ar_[256 + tid] = v2_; ar_[384 + tid] = v3_; ar_[512 + tid] = v4_; } \
        } else if (tid < 128) { ar_[tid] = (float)tid * lg; ar_[128 + tid] = -(float)tid * lg; ar_[256 + tid] = __expf((float)(tid + 1) * lg); ar_[384 + tid] = __expf((float)(127 - tid) * lg); ar_[512 + tid] = 0.f; } \
    } while (0)
#define MIX_ARRAYS(c_) MIX_ARRAYS_TO(c_, (c_) & 1)

    f32x4 Cacc[2][NDB];
#pragma unroll
    for (int xb = 0; xb < 2; ++xb)
#pragma unroll
        for (int yb = 0; yb < NDB; ++yb) Cacc[xb][yb] = (f32x4){0.f, 0.f, 0.f, 0.f};

    if (ML) {
        { const int bufi = tid >> 8, tile = (tid >> 7) & 1, rr = (tid >> 3) & 15, pc = tid & 7; unsigned val = rr == 0 ? 0x3F803F80u : 0u; asm volatile("" : "+v"(val));
            *(LAS u32x4*)(lds + VOFF + bufi * VBUF + tile * 10240 + pg8::lds_byte(64 + rr, pc * 8)) = (u32x4){val, val, val, val}; }
    }
#define MIX_LOADKT(nks, rbase) do { _Pragma("unroll") for (int xb = 0; xb < 2; ++xb) _Pragma("unroll") for (int ks = 0; ks < (nks); ++ks) { \
        const u32x2 lo_ = *(const u32x2*)(KTb + (size_t)xb * 16 * MROWS + (rbase) + 32 * ks), hi_ = *(const u32x2*)(KTb + (size_t)xb * 16 * MROWS + (rbase) + 32 * ks + 16); \
        kxp[xb][ks] = (u32x4){lo_.x, lo_.y, hi_.x, hi_.y}; } } while (0)
#define MIX_PACKKT(nks, wsv_) do { _Pragma("unroll") for (int ks = 0; ks < (nks); ++ks) { \
        const f32x4 w0 = *(const LAS f32x4*)((wsv_) + 32 * ks + 4 * fq), w1 = *(const LAS f32x4*)((wsv_) + 32 * ks + 16 + 4 * fq); \
        _Pragma("unroll") for (int xb = 0; xb < 2; ++xb) { const u32x4 r_ = kxp[xb][ks]; u32x4 p; \
            p.x = pk2(bf2f(r_.x & 0xffffu) * w0[0], bf2f(r_.x >> 16) * w0[1]); p.y = pk2(bf2f(r_.y & 0xffffu) * w0[2], bf2f(r_.y >> 16) * w0[3]); \
            p.z = pk2(bf2f(r_.z & 0xffffu) * w1[0], bf2f(r_.z >> 16) * w1[1]); p.w = pk2(bf2f(r_.w & 0xffffu) * w1[2], bf2f(r_.w >> 16) * w1[3]); \
            kxp[xb][ks] = p; } } } while (0)
#define MIX_STEPC(nks, vbase, wcv) do { \
        _Pragma("unroll") for (int xb = 0; xb < 2; ++xb) _Pragma("unroll") for (int yb = 0; yb < NDB; ++yb) Cacc[xb][yb] = Cacc[xb][yb] * (wcv); \
        _Pragma("unroll") for (int ks = 0; ks < (nks); ++ks) { \
            _Pragma("unroll") for (int yb = 0; yb < NDB; ++yb) { \
                const LAS unsigned char* vp = (vbase) + (ks >> 1) * 10240 + (2 * yb + (ks & 1)) * 1024; \
                u32x4 q; { const u32x2 lo = *(const LAS u32x2*)(vp + vof0), hi = *(const LAS u32x2*)(vp + vof1); q.x = lo.x; q.y = lo.y; q.z = hi.x; q.w = hi.y; } \
                const bf16x8 vf = __builtin_bit_cast(bf16x8, q); \
                _Pragma("unroll") for (int xb = 0; xb < 2; ++xb) Cacc[xb][yb] = mfma16(__builtin_bit_cast(bf16x8, kxp[xb][ks]), vf, Cacc[xb][yb]); } \
            __builtin_amdgcn_sched_barrier(0); } \
    } while (0)
#define MIX_WRITE_CBF() do { \
        _Pragma("unroll") for (int xb = 0; xb < 2; ++xb) _Pragma("unroll") for (int yb = 0; yb < NDB; ++yb) { \
            u32x2 o; o.x = pk2(Cacc[xb][yb][0], Cacc[xb][yb][1]); o.y = pk2(Cacc[xb][yb][2], Cacc[xb][yb][3]); \
            *(LAS u32x2*)(lds + COFF + (w >> 1) * 10240 + (2 * yb + (w & 1)) * 1024 + ((fr * 64 + (16 * xb + 4 * fq) * 2) ^ swz)) = o; } \
    } while (0)

    u32x4 kxp[2][4];
    if (tid < 32) {
        float wv = 0.f;
        if (tid < 16) {
            if (ML) { const float Fs = SF[tid + 1], F16 = SF[16], M16 = SM[16], gi = G[(size_t)(ROW_M + tid) * 8 + h]; wv = __expf(F16 - Fs + gi - M16); }
            else wv = __expf((float)(15 - tid) * lg);
        }
        ((LAS float*)(lds + AOFF + ABUF))[384 + tid] = wv;
    }
    if (tid < 256) { const int dv = tid >> 2, s0 = (tid & 3) * 8;
        *(LAS u32x4*)(lds + VOFF + VBUF + pg8::lds_byte(dv, s0)) = *(const u32x4*)(VTb + (size_t)dv * MROWS + ROW_M + s0); }
    MIX_LOADKT(1, ROW_M);
    MIX_DMA(0);
    MIX_ARRAYS(0);
    __syncthreads();
    MIX_PACKKT(1, (LAS float*)(lds + AOFF + ABUF) + 384);
    MIX_STEPC(1, lds + VOFF + VBUF, 0.f);
    bf16x8 qa[8];
    { const bf16* qp = Q + (size_t)(b * 2048 + 16 * tb + fr) * 1024 + h * 256 + 8 * fq;
#pragma unroll
        for (int ks = 0; ks < 8; ++ks) qa[ks] = *(const bf16x8*)(qp + 32 * ks); }
    __syncthreads();
    MIX_WRITE_CBF();

    for (int c = 0; c < 16; ++c) {
        const int r0 = b * 2048 + 128 * c;
        const LAS unsigned char* vb = lds + VOFF + (c & 1) * VBUF;
        const LAS float* rowa = (const LAS float*)(lds + AOFF + (c & 1) * ABUF); const LAS float* colb = rowa + 128; const LAS float* wint = rowa + 256; const LAS float* wsv = rowa + 384; const LAS float* flo = rowa + 512;
        float wc;
        if (ML) { const int t0 = 16 + 128 * c; wc = __expf(SF[t0 + 128] - SF[t0] + SM[t0] - SM[t0 + 128]); } else wc = __expf(128.f * lg);
        const int tl = 16 * tb + fr, tq = tl - 4 * fq; const float ra = rowa[tl];
        bf16x8 sp[4];
#pragma unroll
        for (int hs = 0; hs < 2; ++hs) {
            if (hs == 0 || tb >= 4) {
                f32x4 S[4];
#pragma unroll
                for (int nb = 0; nb < 4; ++nb) S[nb] = (f32x4){0.f, 0.f, 0.f, 0.f};
#pragma unroll
                for (int ks = 0; ks < 8; ++ks)
#pragma unroll
                    for (int nb = 0; nb < 4; ++nb) {
                        const bf16x8 kf = *(const LAS bf16x8*)(lds + KOFF + (ks >> 1) * 16384 + (2 * (4 * hs + nb) + (ks & 1)) * 1024 + boff);
                        S[nb] = mfma16(kf, qa[ks], S[nb]);
                    }
#pragma unroll
                for (int k2 = 0; k2 < 2; ++k2) {
                    u32x4 p;
#pragma unroll
                    for (int hf = 0; hf < 2; ++hf) {
                        const int nbl = 2 * k2 + hf, nb = 4 * hs + nbl; const f32x4 cb = *(const LAS f32x4*)(colb + 16 * nb + 4 * fq); float r[4];
#pragma unroll
                        for (int e = 0; e < 4; ++e) { const float d = __expf(ra + cb[e]); r[e] = ((16 * nb + e) <= tq) ? S[nbl][e] * d : 0.f; }
                        if (hf == 0) { p.x = pk2(r[0], r[1]); p.y = pk2(r[2], r[3]); } else { p.z = pk2(r[0], r[1]); p.w = pk2(r[2], r[3]); }
                    }
                    sp[2 * hs + k2] = __builtin_bit_cast(bf16x8, p);
                }
            } else { sp[2] = (bf16x8){0, 0, 0, 0, 0, 0, 0, 0}; sp[3] = (bf16x8){0, 0, 0, 0, 0, 0, 0, 0}; }
            __builtin_amdgcn_sched_barrier(0);
        }
        asm volatile("s_waitcnt lgkmcnt(0)" ::: "memory"); __builtin_amdgcn_s_barrier(); asm volatile("" ::: "memory");
        const int cn = c < 15 ? c + 1 : 15;
        MIX_DMA_TO(cn, (c + 1) & 1);
        MIX_LOADKT(4, r0);
        __builtin_amdgcn_sched_barrier(0);
        const float wi = wint[tl];
        float scale = 1.f;
        bf16* hp = Hout + (size_t)(r0 + tl) * 1024 + h * 256 + slice * 64 + 4 * fq;
#pragma unroll
        for (int dbi = 0; dbi < NDB; ++dbi) {
            const int db = ML ? (dbi == 0 ? 4 : dbi - 1) : dbi;
            f32x4 o = (f32x4){0.f, 0.f, 0.f, 0.f};
#pragma unroll
            for (int ks = 0; ks < 8; ++ks) {
                const bf16x8 cf = *(const LAS bf16x8*)(lds + COFF + (ks >> 1) * 10240 + (2 * db + (ks & 1)) * 1024 + boff);
                o = mfma16(cf, qa[ks], o);
            }
            o = o * wi;
#pragma unroll
            for (int k2 = 0; k2 < 2; ++k2) {
                const LAS unsigned char* vp = vb + (2 * db + (k2 & 1)) * 1024;
                u32x4 q; { const u32x2 lo = *(const LAS u32x2*)(vp + vof0), hi = *(const LAS u32x2*)(vp + vof1); q.x = lo.x; q.y = lo.y; q.z = hi.x; q.w = hi.y; }
                o = mfma16(__builtin_bit_cast(bf16x8, q), sp[k2], o);
            }
            if (tb >= 4) {
#pragma unroll
                for (int k2 = 2; k2 < 4; ++k2) {
                    const LAS unsigned char* vp = vb + 10240 + (2 * db + (k2 & 1)) * 1024;
                    u32x4 q; { const u32x2 lo = *(const LAS u32x2*)(vp + vof0), hi = *(const LAS u32x2*)(vp + vof1); q.x = lo.x; q.y = lo.y; q.z = hi.x; q.w = hi.y; }
                    o = mfma16(__builtin_bit_cast(bf16x8, q), sp[k2], o);
                }
            }
            if (ML && dbi == 0) { const float den = __shfl(o[0], fr); scale = 1.f / fmaxf(fabsf(den), flo[tl]); }
            else { u32x2 ov; ov.x = pk2(o[0] * scale, o[1] * scale); ov.y = pk2(o[2] * scale, o[3] * scale); *(u32x2*)(hp + 16 * db) = ov; }
            __builtin_amdgcn_sched_barrier(0);
        }
        MIX_PACKKT(4, wsv);
        __builtin_amdgcn_sched_barrier(0);
        {
            const bf16* qp = Q + (size_t)(b * 2048 + 128 * cn + 16 * tb + fr) * 1024 + h * 256 + 8 * fq;
#pragma unroll
            for (int ks = 0; ks < 8; ++ks) qa[ks] = *(const bf16x8*)(qp + 32 * ks);
            MIX_ARRAYS_TO(cn, (c + 1) & 1);
        }
        __builtin_amdgcn_sched_barrier(0);
        MIX_STEPC(4, vb, wc);
        asm volatile("s_waitcnt vmcnt(0)" ::: "memory");
        __syncthreads();
        MIX_WRITE_CBF();
    }
    float* oC = a.out + (ML ? O_PC : O_PS) + (size_t)bh * 65536;
#pragma unroll
    for (int xb = 0; xb < 2; ++xb)
#pragma unroll
        for (int yb = 0; yb < 4; ++yb)
#pragma unroll
            for (int e = 0; e < 4; ++e) oC[(size_t)(32 * w + 16 * xb + 4 * fq + e) * 256 + slice * 64 + 16 * yb + fr] = Cacc[xb][yb][e];
    if (ML && slice == 0) {
        if (fr == 0) {
#pragma unroll
            for (int xb = 0; xb < 2; ++xb)
#pragma unroll
                for (int e = 0; e < 4; ++e) a.out[O_PN + (size_t)bh * 256 + 32 * w + 16 * xb + 4 * fq + e] = Cacc[xb][NDB - 1][e];
        }
        if (tid == 0) a.out[O_PM + bh] = SM[2064];
    }
    __syncthreads();
#undef MIX_STEPC
#undef MIX_WRITE_CBF
#undef MIX_LOADKT
#undef MIX_PACKKT
#undef MIX_DMA
#undef MIX_ARRAYS
#undef MIX_DMA_TO
#undef MIX_ARRAYS_TO
}

__device__ __forceinline__ void sample_unit(const Args& a, LAS unsigned char* lds, int branch, int n, int h) {
    int tid_ = threadIdx.x; asm volatile("" : "+v"(tid_));
    const int tid = tid_, w = __builtin_amdgcn_readfirstlane(tid >> 6), lane = tid & 63;
    unsigned char* ws = a.ws; const bool ML = branch == 0;
    const int row = ROW_S + n, nh = n * 4 + h;
    const bf16* Q = (const bf16*)(ws + WS_PROJ + (size_t)(ML ? 0 : 3) * SLOT);
    const bf16* Kr = (const bf16*)(ws + WS_PROJ + (size_t)(ML ? 1 : 4) * SLOT);
    const bf16* VT = (const bf16*)(ws + WS_PROJ + (size_t)(ML ? 9 : 11) * SLOT);
    bf16* Hout = (bf16*)(ws + (ML ? WS_HA : WS_HB));
    const float* G = (const float*)(ws + WS_G);
    const float* inC = (ML ? a.st_C : a.st_S) + (size_t)nh * 65536;
    float* outC = a.out + (ML ? O_SC : O_SS) + (size_t)nh * 65536;
    float ca, cb, mnew = 0.f;
    if (ML) { const float gi = G[(size_t)row * 8 + h], gf = logsigf_(G[(size_t)row * 8 + 4 + h]), m = a.st_m[nh]; mnew = fmaxf(gf + m, gi); ca = expf(gf + m - mnew); cb = expf(gi - mnew); }
    else { ca = 1.f - exp2f(-5.f - (float)h); cb = 1.f; }
    LAS float* sq = (LAS float*)lds; LAS float* sk = sq + 256; LAS float* sv = sq + 512; LAS float* red = sq + 768; LAS float* sden = red + 2048;
    if (tid < 256) { sq[tid] = bf2f(Q[(size_t)row * 1024 + h * 256 + tid]); sk[tid] = cb * bf2f(Kr[(size_t)row * 1024 + h * 256 + tid]); sv[tid] = bf2f(VT[(size_t)(h * 256 + tid) * MROWS + row]); }
    __syncthreads();
    const f32x4 v4 = ((const LAS f32x4*)sv)[lane];
    f32x4 acc = (f32x4){0.f, 0.f, 0.f, 0.f};
#pragma unroll 8
    for (int i = 0; i < 32; ++i) {
        const int r = w + 8 * i;
        const f32x4 c4 = ((const f32x4*)(inC + (size_t)r * 256))[lane];
        const f32x4 cn = c4 * ca + v4 * sk[r];
        ((f32x4*)(outC + (size_t)r * 256))[lane] = cn;
        acc += cn * sq[r];
    }
    ((LAS f32x4*)(red + w * 256))[lane] = acc;
    float dpart = 0.f;
    if (ML && tid < 256) { const float nn = ca * a.st_n[(size_t)nh * 256 + tid] + sk[tid]; a.out[O_SN + (size_t)nh * 256 + tid] = nn; dpart = sq[tid] * nn; }
    if (ML) { dpart = wave_sum(dpart); if (lane == 0) sden[w] = dpart; }
    __syncthreads();
    if (tid < 256) {
        float o = 0.f;
#pragma unroll
        for (int k = 0; k < 8; ++k) o += red[k * 256 + tid];
        if (ML) { const float den = sden[0] + sden[1] + sden[2] + sden[3]; o = o / fmaxf(fabsf(den), expf(-mnew)); }
        Hout[(size_t)row * 1024 + h * 256 + tid] = (bf16)f2bf(o);
    }
    if (ML && tid == 0) a.out[O_SM + nh] = mnew;
    __syncthreads();
}

__device__ __forceinline__ void p3_row_load(const bf16* HA, const bf16* HB, const bf16* MO, const bf16* RG, const bf16* GA, const bf16* GB, int row, int lane, u32x2 (&d)[4][6]) {
#pragma unroll
    for (int hh = 0; hh < 4; ++hh) { const size_t off = (size_t)row * 1024 + hh * 256;
        d[hh][0] = ((const u32x2*)(HA + off))[lane]; d[hh][1] = ((const u32x2*)(HB + off))[lane]; d[hh][2] = ((const u32x2*)(MO + off))[lane];
        d[hh][3] = ((const u32x2*)(RG + off))[lane]; d[hh][4] = ((const u32x2*)(GA + off))[lane]; d[hh][5] = ((const u32x2*)(GB + off))[lane]; }
}
__device__ __forceinline__ void p3_row_compute(const Args& a, bf16* MG, int row, int lane, const u32x2 (&d)[4][6]) {
#pragma unroll
    for (int hh = 0; hh < 4; ++hh) {
        const size_t off = (size_t)row * 1024 + hh * 256;
        const u32x2 ra = d[hh][0], rb = d[hh][1], go = d[hh][2], gg = d[hh][3], g1 = d[hh][4], g2 = d[hh][5];
        float xa[4] = {bf2f(ra.x & 0xffffu), bf2f(ra.x >> 16), bf2f(ra.y & 0xffffu), bf2f(ra.y >> 16)};
        float xb[4] = {bf2f(rb.x & 0xffffu), bf2f(rb.x >> 16), bf2f(rb.y & 0xffffu), bf2f(rb.y >> 16)};
        const float ma = wave_sum((xa[0] + xa[1]) + (xa[2] + xa[3])) * (1.f / 256.f), mb = wave_sum((xb[0] + xb[1]) + (xb[2] + xb[3])) * (1.f / 256.f);
        float qa = 0.f, qb = 0.f;
#pragma unroll
        for (int i = 0; i < 4; ++i) { xa[i] -= ma; xb[i] -= mb; qa += xa[i] * xa[i]; qb += xb[i] * xb[i]; }
        const float rsa = 1.f / sqrtf(wave_sum(qa) * (1.f / 256.f) + LN_EPS), rsb = 1.f / sqrtf(wave_sum(qb) * (1.f / 256.f) + LN_EPS);
        const f32x4 ga = ((const f32x4*)(a.ml_g + hh * 256))[lane], gb = ((const f32x4*)(a.rt_g + hh * 256))[lane];
        const float fo[4] = {bf2f(go.x & 0xffffu), bf2f(go.x >> 16), bf2f(go.y & 0xffffu), bf2f(go.y >> 16)};
        const float fg[4] = {bf2f(gg.x & 0xffffu), bf2f(gg.x >> 16), bf2f(gg.y & 0xffffu), bf2f(gg.y >> 16)};
        const float f1[4] = {bf2f(g1.x & 0xffffu), bf2f(g1.x >> 16), bf2f(g1.y & 0xffffu), bf2f(g1.y >> 16)};
        const float f2[4] = {bf2f(g2.x & 0xffffu), bf2f(g2.x >> 16), bf2f(g2.y & 0xffffu), bf2f(g2.y >> 16)};
        float r[4];
#pragma unroll
        for (int i = 0; i < 4; ++i) r[i] = f1[i] * (xa[i] * rsa * ga[i] * fo[i]) + f2[i] * (xb[i] * rsb * gb[i] * fg[i]);
        u32x2 o; o.x = pk2(r[0], r[1]); o.y = pk2(r[2], r[3]);
        ((u32x2*)(MG + off))[lane] = o;
    }
}
__device__ __forceinline__ void p3_merge(const Args& a) {
    const int tid = opaque_tid(), lane = tid & 63, wave = tid >> 6; const int gw = blockIdx.x * 8 + wave, NGW = gridDim.x * 8;
    unsigned char* ws = a.ws;
    const bf16* HA = (const bf16*)(ws + WS_HA); const bf16* HB = (const bf16*)(ws + WS_HB);
    const bf16* MO = (const bf16*)(ws + WS_PROJ + 2 * SLOT); const bf16* RG = (const bf16*)(ws + WS_PROJ + 5 * SLOT);
    const bf16* GA = (const bf16*)(ws + WS_PROJ + 6 * SLOT); const bf16* GB = (const bf16*)(ws + WS_PROJ + 7 * SLOT);
    bf16* MG = (bf16*)(ws + WS_XB);
    for (int row = ROW_V + gw; row < MROWS; row += NGW) {
#pragma unroll
        for (int hh = 0; hh < 4; ++hh) ((u32x2*)(MG + (size_t)row * 1024 + hh * 256))[lane] = (u32x2){0u, 0u};
    }
    for (int row = gw; row < ROW_V; row += 2 * NGW) {
        const int rowB = row + NGW; const bool hasB = rowB < ROW_V;
        u32x2 dA[4][6], dB[4][6];
        p3_row_load(HA, HB, MO, RG, GA, GB, row, lane, dA);
        p3_row_load(HA, HB, MO, RG, GA, GB, hasB ? rowB : row, lane, dB);
        p3_row_compute(a, MG, row, lane, dA);
        if (hasB) p3_row_compute(a, MG, rowB, lane, dB);
    }
}
template <bool FINAL>
__device__ __forceinline__ void ln_row_load(const float* src, const float* sbase, const float* part, int npart, int row, int lane, f32x4 (&v)[4]) {
    if (row < ROW_S) {
#pragma unroll
        for (int j = 0; j < 4; ++j) v[j] = ((const f32x4*)(src + (size_t)row * 1024))[lane + 64 * j];
    } else {
        const int r = row - ROW_S;
#pragma unroll
        for (int j = 0; j < 4; ++j) v[j] = ((const f32x4*)(sbase + (size_t)r * 1024))[lane + 64 * j] * ALPHA;
        for (int p = 0; p < npart; ++p)
#pragma unroll
            for (int j = 0; j < 4; ++j) v[j] += ((const f32x4*)(part + ((size_t)p * 128 + r) * 1024))[lane + 64 * j];
    }
}
template <bool FINAL>
__device__ __forceinline__ void ln_row_finish(const Args& a, int row, int lane, f32x4 (&v)[4], const f32x4 (&gv)[4], const f32x4 (&bv)[4]) {
    float* X1 = (float*)(a.ws + WS_X1); bf16* X1B = (bf16*)(a.ws + WS_X1B);
    float s = 0.f;
#pragma unroll
    for (int j = 0; j < 4; ++j) s += (v[j][0] + v[j][1]) + (v[j][2] + v[j][3]);
    const float mean = wave_sum(s) * (1.f / 1024.f); float q = 0.f;
#pragma unroll
    for (int j = 0; j < 4; ++j) { v[j] = v[j] - mean; q += (v[j][0] * v[j][0] + v[j][1] * v[j][1]) + (v[j][2] * v[j][2] + v[j][3] * v[j][3]); }
    const float rstd = 1.f / sqrtf(wave_sum(q) * (1.f / 1024.f) + LN_EPS);
#pragma unroll
    for (int j = 0; j < 4; ++j) {
        const f32x4 y = v[j] * rstd * gv[j] + bv[j];
        if (FINAL) { ((f32x4*)(a.out + (size_t)row * 1024))[lane + 64 * j] = y; }
        else { ((f32x4*)(X1 + (size_t)row * 1024))[lane + 64 * j] = y; u32x2 o; o.x = pk2(y[0], y[1]); o.y = pk2(y[2], y[3]); ((u32x2*)(X1B + (size_t)row * 1024))[lane + 64 * j] = o; }
    }
}
template <bool FINAL>
__device__ __forceinline__ void ln_phase(const Args& a, const float* src, const float* g, const float* bta, const float* sbase, const float* part, int npart) {
    const int tid = opaque_tid(), lane = tid & 63, wave = tid >> 6; const int gw = blockIdx.x * 8 + wave, NGW = gridDim.x * 8;
    bf16* X1B = (bf16*)(a.ws + WS_X1B);
    f32x4 gv[4], bv[4];
#pragma unroll
    for (int j = 0; j < 4; ++j) { gv[j] = ((const f32x4*)g)[lane + 64 * j]; bv[j] = ((const f32x4*)bta)[lane + 64 * j]; }
    if (!FINAL) for (int row = ROW_V + gw; row < MROWS; row += NGW) {
#pragma unroll
        for (int j = 0; j < 4; ++j) ((u32x2*)(X1B + (size_t)row * 1024))[lane + 64 * j] = (u32x2){0u, 0u};
    }
    for (int row = gw; row < ROW_V; row += 2 * NGW) {
        const int rowB = row + NGW; const bool hasB = rowB < ROW_V;
        f32x4 vA[4], vB[4];
        ln_row_load<FINAL>(src, sbase, part, npart, row, lane, vA);
        ln_row_load<FINAL>(src, sbase, part, npart, hasB ? rowB : row, lane, vB);
        ln_row_finish<FINAL>(a, row, lane, vA, gv, bv);
        if (hasB) ln_row_finish<FINAL>(a, rowB, lane, vB, gv, bv);
    }
}

#define XB_TMO      128
#define XB_XCNT(j)  (256  + 64 * (j))
#define XB_XSUB(j)  (1280 + 64 * (j))
#define XB_XGEN(j)  (2304 + 64 * (j))
#define XB_TOP      3328
#define XB_TOPGEN   3392
#define XCD_BAR_WORDS 3456
#define XB_SPIN_CAP (1u << 18)

__device__ __forceinline__ unsigned xb_ld(unsigned* p)              { return __hip_atomic_load(p, __ATOMIC_RELAXED, __HIP_MEMORY_SCOPE_AGENT); }
__device__ __forceinline__ unsigned xb_add(unsigned* p, unsigned v) { return __hip_atomic_fetch_add(p, v, __ATOMIC_RELAXED, __HIP_MEMORY_SCOPE_AGENT); }
__device__ __forceinline__ unsigned xb_xcc_id() { return (unsigned)__builtin_amdgcn_s_getreg((3 << 11) | 20) & 0xFu; }
#define XB_SPIN(cond, bar) do { unsigned _sp = 0; while (cond) { __builtin_amdgcn_s_sleep(1); \
    if ((++_sp & 255u) == 0u) { if (xb_ld(&(bar)[XB_TMO])) break; if (_sp > XB_SPIN_CAP) { atomicAdd(&(bar)[XB_TMO], 1u); break; } } } } while (0)

struct XcdBarrier {
    unsigned* bar; unsigned x;
    volatile LAS unsigned* st;
};

__device__ __forceinline__ XcdBarrier xcd_barrier_post(unsigned* bar, volatile LAS unsigned* st) {
    XcdBarrier b; b.bar = bar; b.x = xb_xcc_id(); b.st = st;
    if (threadIdx.x == 0) (void)xb_add(&bar[XB_XCNT(b.x)], 1u);
    return b;
}
__device__ __forceinline__ void xcd_barrier_complete(unsigned* bar, unsigned x, unsigned& nloc, unsigned& nx) {
    const unsigned G = gridDim.x * gridDim.y * gridDim.z;
    unsigned sum, cnt, mine, sp = 0u;
    for (;;) {
        sum = 0u; cnt = 0u; mine = 0u;
#pragma unroll
        for (unsigned j = 0; j < 16; ++j) { const unsigned c = xb_ld(&bar[XB_XCNT(j)]); sum += c; cnt += (c > 0u) ? 1u : 0u; mine = (j == x) ? c : mine; }
        if (sum == G) break;
        __builtin_amdgcn_s_sleep(1);
        if ((++sp & 255u) == 0u) { if (xb_ld(&bar[XB_TMO])) break; if (sp > XB_SPIN_CAP) { atomicAdd(&bar[XB_TMO], 1u); break; } }
    }
    nloc = mine > 0u ? mine : 1u; nx = cnt > 0u ? cnt : 1u;
}

__device__ __forceinline__ void xcd_barrier(const XcdBarrier& b) {
    asm volatile("s_waitcnt vmcnt(0)" ::: "memory");
    __syncthreads();
    if (threadIdx.x == 0) {
        unsigned* bar = b.bar;
        __builtin_amdgcn_s_waitcnt(0);
        unsigned nloc = b.st[0], nx = b.st[1];
        if (nloc == 0u) { xcd_barrier_complete(bar, b.x, nloc, nx); b.st[0] = nloc; b.st[1] = nx; }
        const unsigned old = xb_add(&bar[XB_XSUB(b.x)], 1u);
        const unsigned gen = old / nloc;
        if (old + 1u == (gen + 1u) * nloc) {
            __builtin_amdgcn_fence(__ATOMIC_RELEASE, "agent");
            asm volatile("s_waitcnt vmcnt(0)" ::: "memory");
            const unsigned og = xb_add(&bar[XB_TOP], 1u);
            const unsigned tg = og / nx;
            if (og + 1u == (tg + 1u) * nx) xb_add(&bar[XB_TOPGEN], 1u);
            else XB_SPIN(xb_ld(&bar[XB_TOPGEN]) == tg, bar);
            __builtin_amdgcn_fence(__ATOMIC_ACQUIRE, "agent");
            xb_add(&bar[XB_XGEN(b.x)], 1u);
            asm volatile("s_waitcnt vmcnt(0)" ::: "memory");
        } else {
            XB_SPIN(xb_ld(&bar[XB_XGEN(b.x)]) == gen, bar);
            __builtin_amdgcn_fence(__ATOMIC_ACQUIRE, "agent");
            asm volatile("s_waitcnt vmcnt(0)" ::: "memory");
        }
    }
    __syncthreads();
}


#ifndef REPEAT_SAMPLE
#define REPEAT_SAMPLE 1
#endif
#ifndef REPEAT_PROMPT
#define REPEAT_PROMPT 1
#endif
__global__ void __launch_bounds__(NTHR, 2) hybrid_fwd(Args a_) {
    extern __shared__ __attribute__((aligned(16))) unsigned char lds_raw[];
    LAS unsigned char* lds = (LAS unsigned char*)lds_raw;
    cg::grid_group grid = cg::this_grid();
    volatile LAS unsigned* bst = (volatile LAS unsigned*)(lds + LDS_BYTES - 64);
    if (threadIdx.x == 0) { bst[0] = 0u; bst[1] = 0u; }
    __syncthreads();
    const XcdBarrier xbar = xcd_barrier_post((unsigned*)(a_.ws + WS_CTL), bst);
#define GRID_SYNC(k) do { if ((k) == 0) grid.sync(); else xcd_barrier(xbar); } while (0)
    const int lo = a_.ph_lo, hi = a_.ph_hi;
#define FRESH_ARGS() auto kp_ = __builtin_amdgcn_kernarg_segment_ptr(); asm volatile("" : "+s"(kp_)); const Args& a = *(const Args*)kp_; unsigned char* ws = a.ws;
#ifdef DBG_STOP
#define PH_MASK ((2 << DBG_STOP) - 1)
#endif
#ifndef PH_MASK
#define PH_MASK 0x1ff
#endif
#define IN(k) (((PH_MASK >> (k)) & 1) && lo <= (k) && (k) < hi)
#ifndef REPEAT_MASK
#define REPEAT_MASK 0
#endif
#define PH_BEGIN(k) for (int r_ = 0; r_ < (((REPEAT_MASK >> (k)) & 1) ? 2 : 1); ++r_) { if (IN(k))
#define PH_END(k) if ((r_ == 0 && ((REPEAT_MASK >> (k)) & 1)) || (IN(k) && IN((k) + 1))) GRID_SYNC(k); }
    PH_BEGIN(0) { FRESH_ARGS() p0_prologue(a, lds); } PH_END(0)
    PH_BEGIN(1) { FRESH_ARGS()
        if (blockIdx.x < 32) { gate_scan(a, lds, blockIdx.x); __syncthreads(); }
        const pg8::Gemm g = mk_gemm((const bf16*)(ws + WS_XB), (const bf16*)(ws + WS_WIN), MROWS, 10240, 1024); pg8::StaticOrder S; S.init(MROWS, 10240, gridDim.x, blockIdx.x);
        EpiProj E{ws, a.b_in};
        pg8::gemm_phase<EpiProj, pg8::StaticOrder, true, true>(lds, g, S, E);
    }
    PH_END(1)
    PH_BEGIN(2) { FRESH_ARGS()
        for (int rp_ = 0; rp_ < REPEAT_PROMPT; ++rp_)
        for (int u = blockIdx.x; u < 256; u += gridDim.x) {
            const int combo = (u & 7) * 8 + ((u >> 3) & 7), slice = u >> 6;
            const int branch = combo >> 5, b = (combo >> 2) & 7, h = combo & 3;
            if (branch == 0) mixer_unit<true>(a, lds, b, h, slice); else mixer_unit<false>(a, lds, b, h, slice);
        }
        for (int rs_ = 0; rs_ < REPEAT_SAMPLE; ++rs_)
        for (int u = blockIdx.x; u < 1024; u += gridDim.x) sample_unit(a, lds, u >> 9, (u & 511) >> 2, u & 3);
    }
    PH_END(2)
    PH_BEGIN(3) { FRESH_ARGS() p3_merge(a); } PH_END(3)
    PH_BEGIN(4) { FRESH_ARGS()
        { const pg8::Gemm g = mk_gemm((const bf16*)(ws + WS_XB), (const bf16*)(ws + WS_WOUT), ROW_S, 1024, 1024); pg8::StaticOrder S; S.init(ROW_S, 1024, gridDim.x, blockIdx.x);
          EpiRes E{a.x_prompt, (float*)(ws + WS_PRE1)};
          pg8::gemm_phase<EpiRes, pg8::StaticOrder, true, true>(lds, g, S, E); }
        { const pg8::Gemm g = mk_gemm_splitk((const bf16*)(ws + WS_XB) + (size_t)ROW_S * 1024, (const bf16*)(ws + WS_WOUT), 4, 1024, 256, 1024); pg8::StaticOrder S; S.init(4 * 256, 1024, gridDim.x, blockIdx.x);
          EpiPart E{(float*)(ws + WS_PART4)};
          pg8::gemm_phase<EpiPart, pg8::StaticOrder, true, true>(lds, g, S, E); }
    }
    PH_END(4)
    PH_BEGIN(5) { FRESH_ARGS() ln_phase<false>(a, (const float*)(ws + WS_PRE1), a.ln1_g, a.ln1_b, a.x_sample, (const float*)(ws + WS_PART4), 4); } PH_END(5)
    PH_BEGIN(6) { FRESH_ARGS()
        const pg8::Gemm g = mk_gemm((const bf16*)(ws + WS_X1B), (const bf16*)(ws + WS_WGU), MROWS, 2 * DFF, 1024); pg8::StaticOrder S; S.init(MROWS, 2 * DFF, gridDim.x, blockIdx.x);
        EpiGU E{(bf16*)(ws + WS_HBUF)};
        pg8::gemm_phase<EpiGU, pg8::StaticOrder, true, true>(lds, g, S, E);
    }
    PH_END(6)
    PH_BEGIN(7) { FRESH_ARGS()
        { const pg8::Gemm g = mk_gemm((const bf16*)(ws + WS_HBUF), (const bf16*)(ws + WS_WDN), ROW_S, 1024, DFF); pg8::StaticOrder S; S.init(ROW_S, 1024, gridDim.x, blockIdx.x);
          EpiRes E{(const float*)(ws + WS_X1), (float*)(ws + WS_PRE2)};
          pg8::gemm_phase<EpiRes, pg8::StaticOrder, true, true>(lds, g, S, E); }
        { const pg8::Gemm g = mk_gemm_splitk((const bf16*)(ws + WS_HBUF) + (size_t)ROW_S * DFF, (const bf16*)(ws + WS_WDN), 11, 1024, 256, DFF); pg8::StaticOrder S; S.init(11 * 256, 1024, gridDim.x, blockIdx.x);
          EpiPart E{(float*)(ws + WS_PART7)};
          pg8::gemm_phase<EpiPart, pg8::StaticOrder, true, true>(lds, g, S, E); }
    }
    PH_END(7)
    PH_BEGIN(8) { FRESH_ARGS() ln_phase<true>(a, (const float*)(ws + WS_PRE2), a.ln2_g, a.ln2_b, (const float*)(ws + WS_X1) + (size_t)ROW_S * 1024, (const float*)(ws + WS_PART7), 11); } PH_END(8)
#ifdef EXTRA_SYNCS
    for (int i_ = 0; i_ < EXTRA_SYNCS; ++i_) GRID_SYNC(1);
#endif
#ifdef DBG_STOP
    if (lo <= 9 && 9 < hi) { FRESH_ARGS()
        if (lo == 0) grid.sync();
        const size_t gt = (size_t)blockIdx.x * NTHR + threadIdx.x, nt = (size_t)gridDim.x * NTHR;
#if DBG_STOP == 1
        const bf16* sy = (const bf16*)(ws + WS_PROJ); const bf16* sc = (const bf16*)(ws + WS_PROJ + 8 * SLOT); const bf16* ss = (const bf16*)(ws + WS_PROJ + 10 * SLOT);
        for (size_t i = gt; i < O_PC; i += nt) a.out[i] = bf2f(sy[i]);
        for (size_t i = gt; i < 33554432; i += nt) { a.out[O_SC + i] = bf2f(sc[i]); a.out[O_SS + i] = bf2f(ss[i]); }
        for (size_t i = O_PC + gt; i < O_SC; i += nt) a.out[i] = 0.f;
        for (size_t i = O_SN + gt; i < O_SS; i += nt) a.out[i] = 0.f;
#elif DBG_STOP == 2
        const bf16* sy = (const bf16*)(ws + WS_HA);
        for (size_t i = gt; i < O_PC; i += nt) a.out[i] = bf2f(sy[i]) + bf2f(sy[i + SLOT / 2]);
#elif DBG_STOP == 0
        const bf16* sy = (const bf16*)(ws + WS_XB); const bf16* sc = (const bf16*)(ws + WS_WIN);
        for (size_t i = gt; i < O_PC; i += nt) a.out[i] = bf2f(sy[i]);
        for (size_t i = gt; i < 33554432; i += nt) { a.out[O_SC + i] = i < 10485760 ? bf2f(sc[i]) : 0.f; a.out[O_SS + i] = i < 8 * MROWS ? ((const float*)(ws + WS_G))[i] : 0.f; }
        for (size_t i = O_PC + gt; i < O_SC; i += nt) a.out[i] = 0.f;
        for (size_t i = O_SN + gt; i < O_SS; i += nt) a.out[i] = 0.f;
#endif
    }
#endif
#undef IN
#undef PH_BEGIN
#undef PH_END
}

#ifndef N_LAUNCH_SPLIT
#define N_LAUNCH_SPLIT 0
#endif
extern "C" void kernel_launch(void* const* d_in, const int* in_sizes, int n_in, void* d_out, int out_size, void* d_ws, size_t ws_size, hipStream_t stream) {
    static int grid = 0;
    if (grid == 0) {
        if (n_in != 19 || ws_size < WS_END) { fprintf(stderr, "kernel_launch: need 19 inputs and %zu bytes of workspace; got %d, %zu\n", (size_t)WS_END, n_in, ws_size); grid = -1; return; }
        int dev = 0, cus = 0, per_cu = 0;
        if (hipGetDevice(&dev) != hipSuccess || hipDeviceGetAttribute(&cus, hipDeviceAttributeMultiprocessorCount, dev) != hipSuccess) { grid = -1; return; }
        if (hipFuncSetAttribute((const void*)hybrid_fwd, hipFuncAttributeMaxDynamicSharedMemorySize, LDS_BYTES) != hipSuccess) { fprintf(stderr, "kernel_launch: hipFuncSetAttribute failed\n"); grid = -1; return; }
        if (hipOccupancyMaxActiveBlocksPerMultiprocessor(&per_cu, (const void*)hybrid_fwd, NTHR, LDS_BYTES) != hipSuccess || per_cu < 1) { fprintf(stderr, "kernel_launch: occupancy query says %d blocks per CU\n", per_cu); grid = -1; return; }
        grid = cus;
    }
    if (grid < 0) return;
    Args a{};
    a.x_prompt = (const float*)d_in[0]; a.x_sample = (const float*)d_in[1]; a.st_C = (const float*)d_in[2]; a.st_n = (const float*)d_in[3]; a.st_m = (const float*)d_in[4]; a.st_S = (const float*)d_in[5];
    a.meta = (const float*)d_in[6]; a.w_in = (const float*)d_in[7]; a.b_in = (const float*)d_in[8]; a.ml_g = (const float*)d_in[9]; a.rt_g = (const float*)d_in[10]; a.w_out = (const float*)d_in[11];
    a.ln1_g = (const float*)d_in[12]; a.ln1_b = (const float*)d_in[13]; a.w_gate = (const float*)d_in[14]; a.w_up = (const float*)d_in[15]; a.w_down = (const float*)d_in[16]; a.ln2_g = (const float*)d_in[17]; a.ln2_b = (const float*)d_in[18];
    a.out = (float*)d_out; a.ws = (unsigned char*)d_ws;
    if (hipMemsetAsync((char*)d_ws + WS_CTL, 0, CTL_BYTES, stream) != hipSuccess) { fprintf(stderr, "kernel_launch: memset of the barrier words failed\n"); return; }
#if N_LAUNCH_SPLIT
    for (int p = 0; p < 10; ++p) { a.ph_lo = p; a.ph_hi = p + 1; hipLaunchKernelGGL(hybrid_fwd, dim3(grid), dim3(NTHR), LDS_BYTES, stream, a); }
#else
    a.ph_lo = 0; a.ph_hi = 10;
    void* args[] = {&a};
    hipError_t e = hipLaunchCooperativeKernel((const void*)hybrid_fwd, dim3(grid), dim3(NTHR), args, LDS_BYTES, stream);
    if (e != hipSuccess) fprintf(stderr, "kernel_launch: cooperative launch failed: %s (grid %d)\n", hipGetErrorString(e), grid);
#endif
}
```

```cpp
#include <hip/hip_runtime.h>
#include <hip/hip_cooperative_groups.h>
#include <cstdio>
#include <cstdint>
namespace cg = cooperative_groups;
namespace pg8 {
#define PG8_LAS __attribute__((address_space(3)))
typedef unsigned short bf16_t;
typedef short bf16x8 __attribute__((ext_vector_type(8)));
typedef float f32x4 __attribute__((ext_vector_type(4)));
typedef unsigned u32x4 __attribute__((ext_vector_type(4)));
constexpr int BM = 256, BK = 64, HALF = 128, HTB = HALF * BK * 2  , STAGE_BYTES = 8 * HTB, NXCD = 8, WGM = 8;

__host__ __device__ __forceinline__ int lds_byte(int r, int c) { const int st = (r >> 4) * 2 + (c >> 5), rr = r & 15, cc = c & 31, ob = rr * 64 + cc * 2; return st * 1024 + (ob ^ (((ob >> 9) & 1) << 5)); }
__host__ __device__ __forceinline__ void stage_rc(int b, int& R, int& C) { const int st = b / 1024, sb = b % 1024, swz = sb ^ (((sb >> 9) & 1) << 5); R = (st >> 1) * 16 + swz / 64; C = (st & 1) * 32 + (swz % 64) / 2; }
__host__ __device__ __forceinline__ int perm32(int rho) { const int n = rho >> 4, i = rho & 15; return 8 * (i >> 2) + 4 * n + (i & 3); }

struct Unit { int pm, pn; };
struct Gemm { const bf16_t* A; const bf16_t* Bt; int M, N, K; int ld; size_t a_pm, b_pm, b_pn; };

struct StaticOrder {
    int nM, nN, nwg, G, c;
    __host__ __device__ void init(int M, int N, int G_, int c_) { nM = M / BM; nN = N / BM; nwg = nM * nN; G = G_; c = c_; }
    __host__ __device__ bool next(int i, Unit& u) const {
        const long L = (long)i * G + c; if (L >= nwg) return false;
        int wgid = (int)L; { const int q = nwg / NXCD, r = nwg % NXCD, xcd = wgid % NXCD, off = wgid / NXCD; wgid = (xcd < r ? xcd * (q + 1) : r * (q + 1) + (xcd - r) * q) + off; }
        const int nig = WGM * nN, gid = wgid / nig, fm = gid * WGM, gsz = (nM - fm) < WGM ? (nM - fm) : WGM;
        u.pm = fm + ((wgid % nig) % gsz); u.pn = (wgid % nig) / gsz; return true;
    }
    __device__ __forceinline__ void a_ready(const Unit&) const {}
    __device__ __forceinline__ void done(const Unit&) const {}
};

__device__ __forceinline__ unsigned cvt_pk_bf16(float lo, float hi) { unsigned r; asm volatile("v_cvt_pk_bf16_f32 %0, %1, %2" : "=v"(r) : "v"(lo), "v"(hi)); return r; }
template <class Epi, class Sched, bool ALIGN_EPI = false, bool SP2 = false>
__device__ __forceinline__ void gemm_phase(PG8_LAS unsigned char* lds, const Gemm g, const Sched& S, const Epi& E) {
    const int tid = threadIdx.x, wid = __builtin_amdgcn_readfirstlane(tid >> 6), lane = tid & 63, wr = wid >> 2, wc = wid & 3, fr = lane & 15, fq = lane >> 4;
    const int K = g.K, nt = K / BK;
    unsigned voffA[2], voffB[2];
#pragma unroll
    for (int i = 0; i < 2; ++i) { int R, C; stage_rc(tid * 16 + i * 8192, R, C); const int Rb = Epi::PERM ? ((R & ~31) + perm32(R & 31)) : R;
        voffA[i] = (unsigned)(R * g.ld + C) * 2u; voffB[i] = (unsigned)(Rb * g.ld + C) * 2u; }
    const size_t kstep = (size_t)(BK * 2);
    const size_t hstep = (size_t)HALF * g.ld * 2;
    const size_t tstep = 2 * hstep;
    const unsigned ldsw = (unsigned)wid * 1024u;
    const int aoff = lds_byte(wr * 64 + fr, fq * 8), boff = lds_byte(wc * 32 + fr, fq * 8);
#define PG8_SA(b, h) (((b) * 2 + (h)) * HTB)
#define PG8_SB(b, h) ((4 + (b) * 2 + (h)) * HTB)
#define PG8_STAGE(bufoff, gbase, voff) do { _Pragma("unroll") for (int _i = 0; _i < 2; ++_i) \
        __builtin_amdgcn_global_load_lds((const unsigned*)((const char*)(gbase) + (voff)[_i]), (PG8_LAS unsigned*)(lds + (bufoff) + ldsw + _i * 8192), 16, 0, 0); } while (0)
#define PG8_LDA(dst, b, h) do { _Pragma("unroll") for (int m = 0; m < 4; ++m) _Pragma("unroll") for (int k = 0; k < 2; ++k) dst[m][k] = *(const PG8_LAS bf16x8*)(lds + PG8_SA(b, h) + aoff + m * 2048 + k * 1024); } while (0)
#define PG8_LDB(dst, b, h) do { _Pragma("unroll") for (int n = 0; n < 2; ++n) _Pragma("unroll") for (int k = 0; k < 2; ++k) dst[n][k] = *(const PG8_LAS bf16x8*)(lds + PG8_SB(b, h) + boff + n * 2048 + k * 1024); } while (0)
#define PG8_MMA(ai, bj, At, Bt) do { __builtin_amdgcn_s_setprio(1); _Pragma("unroll") for (int m = 0; m < 4; ++m) _Pragma("unroll") for (int n = 0; n < 2; ++n) _Pragma("unroll") for (int k = 0; k < 2; ++k) \
        acc[ai][bj][m][n] = __builtin_amdgcn_mfma_f32_16x16x32_bf16(Bt[n][k], At[m][k], acc[ai][bj][m][n], 0, 0, 0); __builtin_amdgcn_s_setprio(0); } while (0)
#define PG8_WAIT_V(n) asm volatile("s_waitcnt vmcnt(" #n ")" ::: "memory")
#define PG8_WAIT_L(n) asm volatile("s_waitcnt lgkmcnt(" #n ")" ::: "memory")
#define PG8_BAR __builtin_amdgcn_s_barrier()
#define PG8_SCHED __builtin_amdgcn_sched_barrier(0)
    Unit cur, nxt; int ui = 0;
    if (!S.next(0, cur)) return;
    f32x4 acc[2][2][4][2];
#pragma unroll
    for (int a = 0; a < 2; ++a)
#pragma unroll
        for (int b = 0; b < 2; ++b)
#pragma unroll
            for (int m = 0; m < 4; ++m)
#pragma unroll
                for (int n = 0; n < 2; ++n) acc[a][b][m][n] = (f32x4){0.f, 0.f, 0.f, 0.f};
    bf16x8 At[4][2], B0[2][2], B1[2][2];
    const char* cA = (const char*)g.A + (size_t)cur.pm * g.a_pm; const char* cB = (const char*)g.Bt + (size_t)cur.pm * g.b_pm + (size_t)cur.pn * g.b_pn;
    S.a_ready(cur);
    if constexpr (SP2) {
        PG8_STAGE(PG8_SB(0, 0), cB, voffB); PG8_STAGE(PG8_SB(0, 1), cB + hstep, voffB); PG8_STAGE(PG8_SA(0, 0), cA, voffA); PG8_STAGE(PG8_SA(0, 1), cA + hstep, voffA);
        if (wr == 1) PG8_BAR;
        PG8_WAIT_V(2); PG8_BAR;
        PG8_STAGE(PG8_SB(1, 0), cB + kstep, voffB); PG8_STAGE(PG8_SA(1, 0), cA + kstep, voffA); PG8_STAGE(PG8_SB(1, 1), cB + hstep + kstep, voffB);
        PG8_WAIT_V(6); PG8_BAR;
    } else {
        PG8_STAGE(PG8_SB(0, 0), cB, voffB); PG8_STAGE(PG8_SA(0, 0), cA, voffA); PG8_STAGE(PG8_SB(0, 1), cB + hstep, voffB); PG8_STAGE(PG8_SA(0, 1), cA + hstep, voffA);
        if (wr == 1) PG8_BAR;
        PG8_WAIT_V(4); PG8_BAR;
        PG8_STAGE(PG8_SB(1, 0), cB + kstep, voffB); PG8_STAGE(PG8_SA(1, 0), cA + kstep, voffA); PG8_STAGE(PG8_SB(1, 1), cB + hstep + kstep, voffB);
        PG8_WAIT_V(6); PG8_BAR;
    }
    for (;;) {
        const bool has_next = S.next(ui + 1, nxt);
        const char* nA = has_next ? (const char*)g.A + (size_t)nxt.pm * g.a_pm : cA; const char* nB = has_next ? (const char*)g.Bt + (size_t)nxt.pm * g.b_pm + (size_t)nxt.pn * g.b_pn : cB;
        for (int t = 0; t < nt; t += 2) {
            const bool last = (t == nt - 2);
            const char* a1 = cA + (size_t)(t + 1) * kstep;
            const char* a2 = last ? nA : cA + (size_t)(t + 2) * kstep; const char* b2 = last ? nB : cB + (size_t)(t + 2) * kstep;
            const char* a3 = a2 + kstep; const char* b3 = b2 + kstep;
            if (last && has_next) S.a_ready(nxt);
            if constexpr (SP2) {
            PG8_LDB(B0, 0, 0); PG8_LDB(B1, 0, 1); PG8_SCHED; PG8_LDA(At, 0, 0); PG8_STAGE(PG8_SA(1, 1), a1 + hstep, voffA);
            PG8_WAIT_V(8); PG8_WAIT_L(0); PG8_BAR; PG8_MMA(0, 0, At, B0); PG8_MMA(0, 1, At, B1); PG8_BAR; PG8_SCHED;
            PG8_LDA(At, 0, 1); PG8_STAGE(PG8_SB(0, 0), b2, voffB); PG8_STAGE(PG8_SB(0, 1), b2 + hstep, voffB); PG8_STAGE(PG8_SA(0, 0), a2, voffA);
            PG8_WAIT_V(8); PG8_WAIT_L(0); PG8_BAR; PG8_MMA(1, 0, At, B0); PG8_MMA(1, 1, At, B1); PG8_BAR; PG8_SCHED;
            PG8_LDB(B0, 1, 0); PG8_LDB(B1, 1, 1); PG8_SCHED; PG8_LDA(At, 1, 0); PG8_STAGE(PG8_SA(0, 1), a2 + hstep, voffA);
            PG8_WAIT_V(8); PG8_WAIT_L(0); PG8_BAR; PG8_MMA(0, 0, At, B0); PG8_MMA(0, 1, At, B1); PG8_BAR; PG8_SCHED;
            PG8_LDA(At, 1, 1); PG8_STAGE(PG8_SB(1, 0), b3, voffB); PG8_STAGE(PG8_SB(1, 1), b3 + hstep, voffB); PG8_STAGE(PG8_SA(1, 0), a3, voffA);
            PG8_WAIT_V(8); PG8_WAIT_L(0); PG8_BAR; PG8_MMA(1, 0, At, B0); PG8_MMA(1, 1, At, B1); PG8_BAR; PG8_SCHED;
            } else {
            PG8_LDB(B0, 0, 0); PG8_SCHED; PG8_LDA(At, 0, 0); PG8_STAGE(PG8_SA(1, 1), a1 + hstep, voffA);
            PG8_WAIT_L(8); PG8_BAR; PG8_WAIT_L(0); PG8_MMA(0, 0, At, B0); PG8_BAR; PG8_SCHED;
            PG8_LDB(B1, 0, 1); PG8_STAGE(PG8_SB(0, 0), b2, voffB);
            PG8_BAR; PG8_WAIT_L(0); PG8_MMA(0, 1, At, B1); PG8_BAR;
            PG8_LDA(At, 0, 1); PG8_STAGE(PG8_SA(0, 0), a2, voffA);
            PG8_BAR; PG8_WAIT_L(0); PG8_MMA(1, 0, At, B0); PG8_BAR; PG8_SCHED;
            PG8_STAGE(PG8_SB(0, 1), b2 + hstep, voffB);
            PG8_WAIT_V(6); PG8_BAR; PG8_MMA(1, 1, At, B1); PG8_BAR;
            PG8_LDB(B0, 1, 0); PG8_SCHED; PG8_LDA(At, 1, 0); PG8_STAGE(PG8_SA(0, 1), a2 + hstep, voffA);
            PG8_WAIT_L(8); PG8_BAR; PG8_WAIT_L(0); PG8_MMA(0, 0, At, B0); PG8_BAR; PG8_SCHED;
            PG8_LDB(B1, 1, 1); PG8_STAGE(PG8_SB(1, 0), b3, voffB);
            PG8_BAR; PG8_WAIT_L(0); PG8_MMA(0, 1, At, B1); PG8_BAR;
            PG8_LDA(At, 1, 1); PG8_STAGE(PG8_SA(1, 0), a3, voffA);
            PG8_BAR; PG8_WAIT_L(0); PG8_MMA(1, 0, At, B0); PG8_BAR; PG8_SCHED;
            PG8_STAGE(PG8_SB(1, 1), b3 + hstep, voffB);
            PG8_WAIT_V(6); PG8_BAR; PG8_MMA(1, 1, At, B1); PG8_BAR;
            }
        }
        if constexpr (ALIGN_EPI) { if (wr == 0) PG8_BAR; }
        if constexpr (!Epi::AFTER_DRAIN) { E(acc, cur, wr, wc, fr, fq); S.done(cur); }
        if (!has_next) break;
#pragma unroll
        for (int a = 0; a < 2; ++a)
#pragma unroll
            for (int b = 0; b < 2; ++b)
#pragma unroll
                for (int m = 0; m < 4; ++m)
#pragma unroll
                    for (int n = 0; n < 2; ++n) acc[a][b][m][n] = (f32x4){0.f, 0.f, 0.f, 0.f};
        cur = nxt; cA = nA; cB = nB; ++ui;
        if constexpr (ALIGN_EPI) { if (wr == 1) PG8_BAR; }
    }
    PG8_WAIT_V(0);
    if constexpr (!ALIGN_EPI) { if (wr == 0) PG8_BAR; }
    PG8_BAR;
    if constexpr (Epi::AFTER_DRAIN) { E.fused(acc, cur, wr, wc, fr, fq, lds, wid, lane); S.done(cur); }
#undef PG8_SA
#undef PG8_SB
#undef PG8_STAGE
#undef PG8_LDA
#undef PG8_LDB
#undef PG8_MMA
#undef PG8_WAIT_V
#undef PG8_WAIT_L
#undef PG8_BAR
#undef PG8_SCHED
}
}

#define LAS __attribute__((address_space(3)))
typedef unsigned short bf16;
typedef float f32x4 __attribute__((ext_vector_type(4)));
typedef short bf16x8 __attribute__((ext_vector_type(8)));
typedef unsigned u32x4 __attribute__((ext_vector_type(4)));
typedef unsigned u32x2 __attribute__((ext_vector_type(2)));

constexpr int NTHR = 512;
constexpr int DM = 1024, NB = 8, SEQ = 2048, NMETA = 16, DEC = 128, NH = 4, HD = 256, DFF = 2816, NCOL_SRC = 10248;
constexpr int MROWS = 16640;
constexpr int ROW_S = 16384, ROW_M = 16512, ROW_V = 16512  ;
constexpr int NPOS = 2065;
constexpr int SCN = 2065;
constexpr float LN_EPS = 1e-5f;
constexpr float ALPHA = 1.189207115002721f;

constexpr size_t MiB = 1u << 20;
constexpr size_t SLOT = (size_t)MROWS * 1024 * 2;
constexpr size_t WS_WIN = 0;
constexpr size_t WS_HA = 0, WS_HB = SLOT;
constexpr size_t WS_XB = 65 * MiB;
constexpr size_t WS_WOUT = WS_XB + SLOT;
constexpr size_t WS_WGU = WS_WOUT + 2 * MiB;
constexpr size_t WS_WDN = WS_WGU + 11 * MiB;
constexpr size_t WS_G = 116 * MiB;
constexpr size_t WS_ROT = 117 * MiB;
constexpr size_t WS_SF = 119 * MiB + 256 * 1024, WS_SM = 119 * MiB + 640 * 1024;
static_assert(WS_ROT + (size_t)NPOS * 128 * 8 <= WS_SF && WS_SF + 32 * SCN * 4 <= WS_SM && WS_SM + 32 * SCN * 4 <= 120 * MiB, "ws map (scan arrays)");
constexpr size_t WS_CTL = 119 * MiB + 960 * 1024, CTL_BYTES = 16384;
constexpr size_t WS_PROJ = 120 * MiB;
constexpr size_t WS_END = WS_PROJ + 12 * SLOT;
constexpr size_t WS_PRE1 = WS_PROJ, WS_X1 = WS_PROJ + 65 * MiB, WS_X1B = WS_PROJ + 130 * MiB, WS_HBUF = WS_PROJ + 163 * MiB, WS_PRE2 = WS_PROJ + 253 * MiB, WS_PART4 = WS_PROJ + 320 * MiB, WS_PART7 = WS_PROJ + 328 * MiB;
static_assert(WS_WDN + (size_t)DM * DFF * 2 <= WS_G && WS_HBUF + (size_t)MROWS * DFF * 2 <= WS_PRE2 && WS_PRE2 + 65 * MiB <= WS_END, "ws map");

constexpr int LDS_BYTES = 155648;
constexpr int KOFF = 0, COFF = 65536, VOFF = COFF + 40960, VBUF = 20480, AOFF = VOFF + 2 * VBUF, ABUF = 2560;
static_assert(AOFF + 2 * ABUF <= LDS_BYTES, "mixer LDS map");

constexpr size_t O_YP = 0, O_YS = 16777216, O_PC = O_YS + 131072, O_PN = O_PC + 2097152, O_PM = O_PN + 8192, O_PS = O_PM + 32,
                 O_SC = O_PS + 2097152, O_SN = O_SC + 33554432, O_SM = O_SN + 131072, O_SS = O_SM + 512;

__device__ __forceinline__ unsigned f2bf(float f) { unsigned u = __builtin_bit_cast(unsigned, f); return (u + 0x7fffu + ((u >> 16) & 1u)) >> 16; }
typedef float f32x2_t __attribute__((ext_vector_type(2)));
typedef __bf16 bf16x2_t __attribute__((ext_vector_type(2)));
__device__ __forceinline__ unsigned pk2(float lo, float hi) { const f32x2_t v = {lo, hi}; const bf16x2_t b = __builtin_convertvector(v, bf16x2_t); return __builtin_bit_cast(unsigned, b); }
__device__ __forceinline__ float bf2f(unsigned h) { return __builtin_bit_cast(float, h << 16); }
__device__ __forceinline__ float wave_sum(float v) {
#pragma unroll
    for (int o = 1; o < 64; o <<= 1) v += __shfl_xor(v, o);
    return v;
}
__device__ __forceinline__ float sigmoidf_(float x) { return 1.f / (1.f + __expf(-x)); }
__device__ __forceinline__ float logsigf_(float x) { return fminf(x, 0.f) - log1pf(expf(-fabsf(x))); }
__device__ __forceinline__ int opaque_tid() { int t = threadIdx.x; asm volatile("" : "+v"(t)); return t; }
__device__ __forceinline__ int posidx(int row) { return row < ROW_S ? (row & 2047) + 16 : (row < ROW_M ? 2064 : (row < ROW_M + 16 ? row - ROW_M : 0)); }

struct Args {
    const float *x_prompt, *x_sample, *st_C, *st_n, *st_m, *st_S, *meta, *w_in, *b_in, *ml_g, *rt_g, *w_out, *ln1_g, *ln1_b, *w_gate, *w_up, *w_down, *ln2_g, *ln2_b;
    float* out; unsigned char* ws; int ph_lo, ph_hi;
};

__device__ __forceinline__ pg8::Gemm mk_gemm(const bf16* A, const bf16* Bt, int M, int N, int K) { return pg8::Gemm{A, Bt, M, N, K, K, (size_t)512 * K, 0, (size_t)512 * K}; }
__device__ __forceinline__ pg8::Gemm mk_gemm_splitk(const bf16* A, const bf16* Bt, int nsplit, int N, int KS, int ld) { return pg8::Gemm{A, Bt, nsplit * 256, N, KS, ld, (size_t)2 * KS, (size_t)2 * KS, (size_t)512 * ld}; }
struct EpiProj {
    static constexpr bool PERM = false, AFTER_DRAIN = false;
    unsigned char* ws; const float* b_in;
    __device__ __forceinline__ void operator()(const f32x4 (&acc)[2][2][4][2], const pg8::Unit& u, int wr, int wc, int fr, int fq) const {
        const int grp = u.pn >> 2, head = u.pn & 3;
        const int rmslot = grp == 0 ? 0 : grp == 1 ? 1 : grp == 3 ? 2 : grp == 4 ? 3 : grp == 5 ? 4 : grp == 7 ? 5 : grp == 8 ? 6 : grp == 9 ? 7 : -1;
        const int tslot = grp == 1 ? 8 : grp == 2 ? 9 : grp == 5 ? 10 : grp == 6 ? 11 : -1;
        const bool rot = (grp == 4 || grp == 5);
        const int act = (grp == 3 || grp >= 8) ? 1 : (grp == 7 ? 2 : 0);
        const float bsc = (grp == 1 || grp == 5) ? 0.0625f : 1.f;
        const int colh = wc * 32 + 4 * fq;
        const float* bsrc = b_in + grp * 1024 + head * 256 + (grp >= 4 ? 8 : 0) + colh;
        f32x4 bv[2][2];
#pragma unroll
        for (int bj = 0; bj < 2; ++bj)
#pragma unroll
            for (int n = 0; n < 2; ++n) bv[bj][n] = *(const f32x4*)(bsrc + bj * 128 + n * 16) * bsc;
        bf16* rm = rmslot >= 0 ? (bf16*)(ws + WS_PROJ + (size_t)rmslot * SLOT) : nullptr;
        bf16* tb = tslot >= 0 ? (bf16*)(ws + WS_PROJ + (size_t)tslot * SLOT) : nullptr;
        const float* rotp = (const float*)(ws + WS_ROT);
#pragma unroll
        for (int ai = 0; ai < 2; ++ai)
#pragma unroll
            for (int m = 0; m < 4; ++m) {
                const int row = u.pm * 256 + ai * 128 + wr * 64 + m * 16 + fr;
                f32x4 v[2][2];
#pragma unroll
                for (int bj = 0; bj < 2; ++bj)
#pragma unroll
                    for (int n = 0; n < 2; ++n) v[bj][n] = acc[ai][bj][m][n] + bv[bj][n];
                if (rot) {
                    const float* cs = rotp + ((size_t)posidx(row) * 128 + colh) * 2;
#pragma unroll
                    for (int n = 0; n < 2; ++n) {
                        const f32x4 c0 = *(const f32x4*)(cs + n * 32), c1 = *(const f32x4*)(cs + n * 32 + 4);
                        const f32x4 x1 = v[0][n], x2 = v[1][n];
                        v[0][n] = (f32x4){x1[0] * c0[0] - x2[0] * c0[1], x1[1] * c0[2] - x2[1] * c0[3], x1[2] * c1[0] - x2[2] * c1[1], x1[3] * c1[2] - x2[3] * c1[3]};
                        v[1][n] = (f32x4){x1[0] * c0[1] + x2[0] * c0[0], x1[1] * c0[3] + x2[1] * c0[2], x1[2] * c1[1] + x2[2] * c1[0], x1[3] * c1[3] + x2[3] * c1[2]};
                    }
                }
                if (act == 1) {
#pragma unroll
                    for (int bj = 0; bj < 2; ++bj)
#pragma unroll
                        for (int n = 0; n < 2; ++n)
#pragma unroll
                            for (int i = 0; i < 4; ++i) v[bj][n][i] = sigmoidf_(v[bj][n][i]);
                } else if (act == 2) {
#pragma unroll
                    for (int bj = 0; bj < 2; ++bj)
#pragma unroll
                        for (int n = 0; n < 2; ++n)
#pragma unroll
                            for (int i = 0; i < 4; ++i) v[bj][n][i] = v[bj][n][i] * sigmoidf_(v[bj][n][i]);
                }
                if (rm) {
                    bf16* rp = rm + (size_t)row * 1024 + head * 256 + colh;
#pragma unroll
                    for (int bj = 0; bj < 2; ++bj)
#pragma unroll
                        for (int n = 0; n < 2; ++n) { u32x2 w; w.x = pk2(v[bj][n][0], v[bj][n][1]); w.y = pk2(v[bj][n][2], v[bj][n][3]); *(u32x2*)(rp + bj * 128 + n * 16) = w; }
                }
#ifndef OPT_DPP
#define OPT_DPP 1
#endif
#if OPT_DPP
                if (tb) {
                    const int qb = fr & 3; const bool odd = qb & 1, hi2 = qb & 2;
                    bf16* tp = tb + (size_t)(head * 256 + colh + qb) * MROWS + (row - qb);
#pragma unroll
                    for (int bj = 0; bj < 2; ++bj)
#pragma unroll
                        for (int n = 0; n < 2; ++n) {
                            const float f0_ = v[bj][n][0], f1_ = v[bj][n][1], f2_ = v[bj][n][2], f3_ = v[bj][n][3];
                            int x0 = __float_as_int(f0_), x1 = __float_as_int(f1_), x2 = __float_as_int(f2_), x3 = __float_as_int(f3_);
                            int a0, a1, a2, a3, b0, b1, b2, b3;
#define DPPX1(d, s_) asm volatile("s_nop 1\n\tv_mov_b32_dpp %0, %1 quad_perm:[1,0,3,2] row_mask:0xf bank_mask:0xf bound_ctrl:1" : "=&v"(d) : "v"(s_))
#define DPPX2(d, s_) asm volatile("s_nop 1\n\tv_mov_b32_dpp %0, %1 quad_perm:[2,3,0,1] row_mask:0xf bank_mask:0xf bound_ctrl:1" : "=&v"(d) : "v"(s_))
                            DPPX1(a0, x0); DPPX1(a1, x1); DPPX1(a2, x2); DPPX1(a3, x3);
                            x0 = odd ? a1 : x0; x1 = odd ? x1 : a0; x2 = odd ? a3 : x2; x3 = odd ? x3 : a2;
                            DPPX2(b0, x0); DPPX2(b1, x1); DPPX2(b2, x2); DPPX2(b3, x3);
                            if (hi2) { x0 = b2; x1 = b3; } else { x2 = b0; x3 = b1; }
#undef DPPX1
#undef DPPX2
                            u32x2 w; w.x = pk2(__int_as_float(x0), __int_as_float(x1)); w.y = pk2(__int_as_float(x2), __int_as_float(x3));
                            *(u32x2*)(tp + (size_t)(bj * 128 + n * 16) * MROWS) = w;
                        }
                }
#else
                if (tb) {
                    bf16* tp = tb + (size_t)(head * 256 + colh) * MROWS + row;
#pragma unroll
                    for (int bj = 0; bj < 2; ++bj)
#pragma unroll
                        for (int n = 0; n < 2; ++n)
#pragma unroll
                            for (int i = 0; i < 4; ++i) tp[(size_t)(bj * 128 + n * 16 + i) * MROWS] = (bf16)f2bf(v[bj][n][i]);
                }
#endif
            }
    }
};
struct EpiRes {
    static constexpr bool PERM = false, AFTER_DRAIN = false;
    const float* base; float* out;
    __device__ __forceinline__ void operator()(const f32x4 (&acc)[2][2][4][2], const pg8::Unit& u, int wr, int wc, int fr, int fq) const {
        const int col0 = u.pn * 256 + wc * 32 + 4 * fq;
#pragma unroll
        for (int ai = 0; ai < 2; ++ai)
#pragma unroll
            for (int m = 0; m < 4; ++m) {
                const int row = u.pm * 256 + ai * 128 + wr * 64 + m * 16 + fr;
                const float* bp = base + (size_t)row * 1024 + col0;
                float* op = out + (size_t)row * 1024 + col0;
#pragma unroll
                for (int bj = 0; bj < 2; ++bj)
#pragma unroll
                    for (int n = 0; n < 2; ++n) { const f32x4 x = *(const f32x4*)(bp + bj * 128 + n * 16); *(f32x4*)(op + bj * 128 + n * 16) = x * ALPHA + acc[ai][bj][m][n]; }
            }
    }
};
struct EpiPart {
    static constexpr bool PERM = false, AFTER_DRAIN = false;
    float* part;
    __device__ __forceinline__ void operator()(const f32x4 (&acc)[2][2][4][2], const pg8::Unit& u, int wr, int wc, int fr, int fq) const {
        const int col0 = u.pn * 256 + wc * 32 + 4 * fq;
#pragma unroll
        for (int m = 0; m < 4; ++m) {
            const int r = wr * 64 + m * 16 + fr;
            float* op = part + ((size_t)u.pm * 128 + r) * 1024 + col0;
#pragma unroll
            for (int bj = 0; bj < 2; ++bj)
#pragma unroll
                for (int n = 0; n < 2; ++n) *(f32x4*)(op + bj * 128 + n * 16) = acc[0][bj][m][n];
        }
    }
};
struct EpiGU {
    static constexpr bool PERM = false, AFTER_DRAIN = false;
    bf16* hb;
    __device__ __forceinline__ void operator()(const f32x4 (&acc)[2][2][4][2], const pg8::Unit& u, int wr, int wc, int fr, int fq) const {
        const int col0 = u.pn * 128 + wc * 32 + 4 * fq;
#pragma unroll
        for (int ai = 0; ai < 2; ++ai)
#pragma unroll
            for (int m = 0; m < 4; ++m) {
                const int row = u.pm * 256 + ai * 128 + wr * 64 + m * 16 + fr;
                bf16* op = hb + (size_t)row * DFF + col0;
#pragma unroll
                for (int n = 0; n < 2; ++n) {
                    const f32x4 g = acc[ai][0][m][n], up = acc[ai][1][m][n]; float r[4];
#pragma unroll
                    for (int i = 0; i < 4; ++i) r[i] = g[i] * sigmoidf_(g[i]) * up[i];
                    u32x2 w; w.x = pk2(r[0], r[1]); w.y = pk2(r[2], r[3]); *(u32x2*)(op + n * 16) = w;
                }
            }
    }
};

__device__ __forceinline__ void transpose_item(const float* W, int ldw, int sc0, int k0, bf16* WT, int ldk, int dr0, float scale, LAS float* scr, int lane) {
#pragma unroll 8
    for (int i = 0; i < 32; ++i) { const int kk = 2 * i + (lane >> 5); scr[kk * 33 + (lane & 31)] = W[(size_t)(k0 + kk) * ldw + sc0 + (lane & 31)] * scale; }
    asm volatile("s_waitcnt lgkmcnt(0)" ::: "memory");
    const int c = lane & 7;
#pragma unroll
    for (int j = 0; j < 4; ++j) { const int n = (lane >> 3) + 8 * j; const LAS float* s = scr + (8 * c) * 33 + n;
        u32x4 o; o.x = pk2(s[0 * 33], s[1 * 33]); o.y = pk2(s[2 * 33], s[3 * 33]); o.z = pk2(s[4 * 33], s[5 * 33]); o.w = pk2(s[6 * 33], s[7 * 33]);
        *(u32x4*)(WT + (size_t)(dr0 + n) * ldk + k0 + 8 * c) = o; }
    asm volatile("s_waitcnt lgkmcnt(0)" ::: "memory");
}

__device__ __forceinline__ void p0_prologue(const Args& a, LAS unsigned char* lds) {
    const int tid = opaque_tid(), lane = tid & 63, wave = __builtin_amdgcn_readfirstlane(tid >> 6);
    const int gw = blockIdx.x * 8 + wave, NGW = gridDim.x * 8;
    unsigned char* ws = a.ws;
    LAS float* scr = (LAS float*)(lds + wave * 8704);
    LAS float* wgt = (LAS float*)(lds + 69632);
    for (int idx = tid; idx < 8192; idx += NTHR) { const int k = idx >> 3, c = idx & 7; wgt[c * 1024 + k] = a.w_in[(size_t)k * NCOL_SRC + 4096 + c]; }
    constexpr int I_IN = 16 * 320, I_OUT = 16 * 32, I_G = 16 * 88, I_D = 44 * 32;
    constexpr int NITEMS = I_IN + I_OUT + 2 * I_G + I_D;
    for (int it = gw; it < NITEMS; it += NGW) {
        int r = it;
        if (r < I_IN) { const int kb = r / 320, nb = r % 320; const float sc = ((nb >= 32 && nb < 64) || (nb >= 160 && nb < 192)) ? 0.0625f : 1.f;
            transpose_item(a.w_in, NCOL_SRC, 32 * nb + (nb >= 128 ? 8 : 0), 64 * kb, (bf16*)(ws + WS_WIN), 1024, 32 * nb, sc, scr, lane); continue; } r -= I_IN;
        if (r < I_OUT) { const int kb = r / 32, nb = r % 32; transpose_item(a.w_out, 1024, 32 * nb, 64 * kb, (bf16*)(ws + WS_WOUT), 1024, 32 * nb, 1.f, scr, lane); continue; } r -= I_OUT;
        if (r < I_G) { const int kb = r / 88, nb = r % 88; transpose_item(a.w_gate, DFF, 32 * nb, 64 * kb, (bf16*)(ws + WS_WGU), 1024, 256 * (nb >> 2) + 32 * (nb & 3), 1.f, scr, lane); continue; } r -= I_G;
        if (r < I_G) { const int kb = r / 88, nb = r % 88; transpose_item(a.w_up, DFF, 32 * nb, 64 * kb, (bf16*)(ws + WS_WGU), 1024, 256 * (nb >> 2) + 128 + 32 * (nb & 3), 1.f, scr, lane); continue; } r -= I_G;
        { const int kb = r / 32, nb = r % 32; transpose_item(a.w_down, 1024, 32 * nb, 64 * kb, (bf16*)(ws + WS_WDN), DFF, 32 * nb, 1.f, scr, lane); }
    }
    __syncthreads();
    bf16* XB = (bf16*)(ws + WS_XB); float* G = (float*)(ws + WS_G);
    for (int row = gw; row < MROWS; row += NGW) {
        const float* src = row < ROW_S ? a.x_prompt + (size_t)row * 1024 : (row < ROW_M ? a.x_sample + (size_t)(row - ROW_S) * 1024 : (row < ROW_M + 16 ? a.meta + (size_t)(row - ROW_M) * 1024 : nullptr));
        f32x4 v[4];
#pragma unroll
        for (int j = 0; j < 4; ++j) v[j] = src ? ((const f32x4*)src)[lane + 64 * j] : (f32x4){0.f, 0.f, 0.f, 0.f};
#pragma unroll
        for (int j = 0; j < 4; ++j) { u32x2 w; w.x = pk2(v[j][0], v[j][1]); w.y = pk2(v[j][2], v[j][3]); ((u32x2*)(XB + (size_t)row * 1024))[lane + 64 * j] = w; }
        float mine = 0.f;
#pragma unroll
        for (int c = 0; c < 8; ++c) {
            float d = 0.f;
#pragma unroll
            for (int j = 0; j < 4; ++j) { const f32x4 wv = ((const LAS f32x4*)(wgt + c * 1024))[lane + 64 * j]; d += v[j][0] * wv[0] + v[j][1] * wv[1] + v[j][2] * wv[2] + v[j][3] * wv[3]; }
            d = wave_sum(d);
            if (lane == c) mine = d;
        }
        if (lane < 8) G[(size_t)row * 8 + lane] = mine + a.b_in[4096 + lane];
    }
    float* rot = (float*)(ws + WS_ROT);
    for (int e = blockIdx.x * NTHR + tid; e < NPOS * 128; e += gridDim.x * NTHR) {
        const int p = e >> 7, j = e & 127;
        double inv = 1.0, rr = 0.930572040929699;
#pragma unroll
        for (int bit = 0; bit < 7; ++bit) { if ((j >> bit) & 1) inv *= rr; rr *= rr; }
        const double pos = (p == 2064) ? 16384.0 : (double)p;
        const double t = pos * inv * 0.15915494309189535; const double fr = t - floor(t);
        const float f = (float)fr;
        rot[2 * e] = __builtin_amdgcn_cosf(f); rot[2 * e + 1] = __builtin_amdgcn_sinf(f);
    }
}

__device__ __forceinline__ void gate_scan(const Args& a, LAS unsigned char* lds, int bh) {
    const int tid = opaque_tid(), b = bh >> 2, h = bh & 3;
    const float* G = (const float*)(a.ws + WS_G);
    float* SF = (float*)(a.ws + WS_SF) + (size_t)bh * SCN; float* SM = (float*)(a.ws + WS_SM) + (size_t)bh * SCN;
    float F = 0.f, M = 0.f;
    if (tid == 0) { SF[0] = 0.f; SM[0] = 0.f; }
    for (int s = 0; s < NMETA; ++s) { const float gi = G[(size_t)(ROW_M + s) * 8 + h], gf = logsigf_(G[(size_t)(ROW_M + s) * 8 + 4 + h]); F += gf; M = fmaxf(M + gf, gi); if (tid == 0) { SF[s + 1] = F; SM[s + 1] = M; } }
    const int row = b * 2048 + 4 * tid;
    float f[4], gi[4], pa = 0.f, pc = -INFINITY;
#pragma unroll
    for (int k = 0; k < 4; ++k) { gi[k] = G[(size_t)(row + k) * 8 + h]; f[k] = logsigf_(G[(size_t)(row + k) * 8 + 4 + h]); pc = fmaxf(pc + f[k], gi[k]); pa += f[k]; }
    LAS float* sa = (LAS float*)lds; LAS float* sc = sa + 512;
    for (int off = 1; off < 512; off <<= 1) {
        sa[tid] = pa; sc[tid] = pc; __syncthreads();
        float la = 0.f, lc = -INFINITY; const bool has = tid >= off;
        if (has) { la = sa[tid - off]; lc = sc[tid - off]; }
        __syncthreads();
        if (has) { pc = fmaxf(lc + pa, pc); pa = la + pa; }
    }
    sa[tid] = pa; sc[tid] = pc; __syncthreads();
    float ea = 0.f, ec = -INFINITY; if (tid > 0) { ea = sa[tid - 1]; ec = sc[tid - 1]; }
    __syncthreads();
    float Fb = F + ea, Mb = fmaxf(M + ea, ec);
#pragma unroll
    for (int k = 0; k < 4; ++k) { Fb += f[k]; Mb = fmaxf(Mb + f[k], gi[k]); SF[17 + 4 * tid + k] = Fb; SM[17 + 4 * tid + k] = Mb; }
}

__device__ __forceinline__ f32x4 mfma16(bf16x8 x, bf16x8 y, f32x4 c) { return __builtin_amdgcn_mfma_f32_16x16x32_bf16(x, y, c, 0, 0, 0); }

template <bool ML>
__device__ __forceinline__ void mixer_unit(const Args& a, LAS unsigned char* lds, int b, int h, int slice) {
    constexpr int NDB = ML ? 5 : 4;
    int tid_ = threadIdx.x; asm volatile("" : "+v"(tid_));
    const int tid = tid_, w = __builtin_amdgcn_readfirstlane(tid >> 6), lane = tid & 63, fr = lane & 15, fq = lane >> 4;
    unsigned char* ws = a.ws;
    const bf16* Q = (const bf16*)(ws + WS_PROJ + (size_t)(ML ? 0 : 3) * SLOT);
    const bf16* Kr = (const bf16*)(ws + WS_PROJ + (size_t)(ML ? 1 : 4) * SLOT);
    const bf16* KT = (const bf16*)(ws + WS_PROJ + (size_t)(ML ? 8 : 10) * SLOT);
    const bf16* VT = (const bf16*)(ws + WS_PROJ + (size_t)(ML ? 9 : 11) * SLOT);
    bf16* Hout = (bf16*)(ws + (ML ? WS_HA : WS_HB));
    const float* G = (const float*)(ws + WS_G);
    const int bh = b * 4 + h;
    const float* SF = (const float*)(ws + WS_SF) + (size_t)bh * SCN; const float* SM = (const float*)(ws + WS_SM) + (size_t)bh * SCN;
    const float lg = log1pf(-exp2f(-5.f - (float)h));
    const int tb = w < 4 ? w : 11 - w;
    const int swz = ((fr >> 3) & 1) << 5;
    const int boff = (fr * 64 + fq * 16) ^ swz;
    const int vof0 = (fr * 64 + fq * 8) ^ swz, vof1 = (fr * 64 + 32 + fq * 8) ^ swz;
    const bf16* KTb = KT + (size_t)(h * 256 + w * 32 + fr) * MROWS + 4 * fq;
    const bf16* VTb = VT + (size_t)(h * 256 + slice * 64) * MROWS;
    int kR[2], kC[2];
#pragma unroll
    for (int i = 0; i < 2; ++i) pg8::stage_rc(tid * 16 + i * 8192, kR[i], kC[i]);
    const bf16* Ksrc0 = Kr + (size_t)kR[0] * 1024 + h * 256 + kC[0]; const bf16* Ksrc1 = Kr + (size_t)kR[1] * 1024 + h * 256 + kC[1];
    int vsrc[2];
#pragma unroll
    for (int j = 0; j < 2; ++j) { const int idx = 2 * w + j, t = idx >> 3, st = idx & 7; const int p = 16 * lane, ob = p ^ (((p >> 9) & 1) << 5), rr = ob >> 6, cc = (ob & 63) >> 1;
        vsrc[j] = ((st >> 1) * 16 + rr) * MROWS + t * 64 + (st & 1) * 32 + cc; }
#define MIX_DMA_TO(c_, buf_) do { const int r0n_ = b * 2048 + 128 * (c_); \
        _Pragma("unroll") for (int kt = 0; kt < 4; ++kt) { \
            __builtin_amdgcn_global_load_lds((const unsigned*)(Ksrc0 + (size_t)r0n_ * 1024 + kt * 64), (LAS unsigned*)(lds + KOFF + kt * 16384 + w * 1024), 16, 0, 0); \
            __builtin_amdgcn_global_load_lds((const unsigned*)(Ksrc1 + (size_t)r0n_ * 1024 + kt * 64), (LAS unsigned*)(lds + KOFF + kt * 16384 + w * 1024 + 8192), 16, 0, 0); } \
        _Pragma("unroll") for (int j = 0; j < 2; ++j) { const int idx = 2 * w + j; \
            __builtin_amdgcn_global_load_lds((const unsigned*)(VTb + vsrc[j] + r0n_), (LAS unsigned*)(lds + VOFF + (buf_) * VBUF + (idx >> 3) * 10240 + (idx & 7) * 1024), 16, 0, 0); } \
    } while (0)
#define MIX_DMA(c_) MIX_DMA_TO(c_, (c_) & 1)
#define MIX_ARRAYS_TO(c_, buf_) do { LAS float* ar_ = (LAS float*)(lds + AOFF + (buf_) * ABUF); const int t0n_ = 16 + 128 * (c_), tj_ = tid & 127; \
        if (ML) { const float Fp = SF[t0n_], Mp = SM[t0n_], Fe = SF[t0n_ + 128], Me = SM[t0n_ + 128]; \
            const float Fj = SF[t0n_ + 1 + tj_], Mj = SM[t0n_ + 1 + tj_], gi = G[(size_t)(b * 2048 + 128 * (c_) + tj_) * 8 + h]; \
            const float v0_ = Fj - Mj, v1_ = gi - Fj, v2_ = __expf(Fj - Fp + Mp - Mj), v3_ = __expf(Fe - Fj + gi - Me), v4_ = __expf(-Mj); \
            if (tid < 128) { ar_[tid] = v0_; ar_[128 + tid] = v1_; ar_[256 + tid] = v2_; ar_[384 + tid] = v3_; ar_[512 + tid] = v4_; } \
        } else if (tid < 128) { ar_[tid] = (float)tid * lg; ar_[128 + tid] = -(float)tid * lg; ar_[256 + tid] = __expf((float)(tid + 1) * lg); ar_[384 + tid] = __expf((float)(127 - tid) * lg); ar_[512 + tid] = 0.f; } \
    } while (0)
#define MIX_ARRAYS(c_) MIX_ARRAYS_TO(c_, (c_) & 1)

    f32x4 Cacc[2][NDB];
#pragma unroll
    for (int xb = 0; xb < 2; ++xb)
#pragma unroll
        for (int yb = 0; yb < NDB; ++yb) Cacc[xb][yb] = (f32x4){0.f, 0.f, 0.f, 0.f};

    if (ML) {
        { const int bufi = tid >> 8, tile = (tid >> 7) & 1, rr = (tid >> 3) & 15, pc = tid & 7; unsigned val = rr == 0 ? 0x3F803F80u : 0u; asm volatile("" : "+v"(val));
            *(LAS u32x4*)(lds + VOFF + bufi * VBUF + tile * 10240 + pg8::lds_byte(64 + rr, pc * 8)) = (u32x4){val, val, val, val}; }
    }
#define MIX_LOADKT(nks, rbase) do { _Pragma("unroll") for (int xb = 0; xb < 2; ++xb) _Pragma("unroll") for (int ks = 0; ks < (nks); ++ks) { \
        const u32x2 lo_ = *(const u32x2*)(KTb + (size_t)xb * 16 * MROWS + (rbase) + 32 * ks), hi_ = *(const u32x2*)(KTb + (size_t)xb * 16 * MROWS + (rbase) + 32 * ks + 16); \
        kxp[xb][ks] = (u32x4){lo_.x, lo_.y, hi_.x, hi_.y}; } } while (0)
#define MIX_PACKKT(nks, wsv_) do { _Pragma("unroll") for (int ks = 0; ks < (nks); ++ks) { \
        const f32x4 w0 = *(const LAS f32x4*)((wsv_) + 32 * ks + 4 * fq), w1 = *(const LAS f32x4*)((wsv_) + 32 * ks + 16 + 4 * fq); \
        _Pragma("unroll") for (int xb = 0; xb < 2; ++xb) { const u32x4 r_ = kxp[xb][ks]; u32x4 p; \
            p.x = pk2(bf2f(r_.x & 0xffffu) * w0[0], bf2f(r_.x >> 16) * w0[1]); p.y = pk2(bf2f(r_.y & 0xffffu) * w0[2], bf2f(r_.y >> 16) * w0[3]); \
            p.z = pk2(bf2f(r_.z & 0xffffu) * w1[0], bf2f(r_.z >> 16) * w1[1]); p.w = pk2(bf2f(r_.w & 0xffffu) * w1[2], bf2f(r_.w >> 16) * w1[3]); \
            kxp[xb][ks] = p; } } } while (0)
#define MIX_STEPC(nks, vbase, wcv) do { \
        _Pragma("unroll") for (int xb = 0; xb < 2; ++xb) _Pragma("unroll") for (int yb = 0; yb < NDB; ++yb) Cacc[xb][yb] = Cacc[xb][yb] * (wcv); \
        _Pragma("unroll") for (int ks = 0; ks < (nks); ++ks) { \
            _Pragma("unroll") for (int yb = 0; yb < NDB; ++yb) { \
                const LAS unsigned char* vp = (vbase) + (ks >> 1) * 10240 + (2 * yb + (ks & 1)) * 1024; \
                u32x4 q; { const u32x2 lo = *(const LAS u32x2*)(vp + vof0), hi = *(const LAS u32x2*)(vp + vof1); q.x = lo.x; q.y = lo.y; q.z = hi.x; q.w = hi.y; } \
                const bf16x8 vf = __builtin_bit_cast(bf16x8, q); \
                _Pragma("unroll") for (int xb = 0; xb < 2; ++xb) Cacc[xb][yb] = mfma16(__builtin_bit_cast(bf16x8, kxp[xb][ks]), vf, Cacc[xb][yb]); } \
            __builtin_amdgcn_sched_barrier(0); } \
    } while (0)
#define MIX_WRITE_CBF() do { \
        _Pragma("unroll") for (int xb = 0; xb < 2; ++xb) _Pragma("unroll") for (int yb = 0; yb < NDB; ++yb) { \
            u32x2 o; o.x = pk2(Cacc[xb][yb][0], Cacc[xb][yb][1]); o.y = pk2(Cacc[xb][yb][2], Cacc[xb][yb][3]); \
            *(LAS u32x2*)(lds + COFF + (w >> 1) * 10240 + (2 * yb + (w & 1)) * 1024 + ((fr * 64 + (16 * xb + 4 * fq) * 2) ^ swz)) = o; } \
    } while (0)

    u32x4 kxp[2][4];
    if (tid < 32) {
        float wv = 0.f;
        if (tid < 16) {
            if (ML) { const float Fs = SF[tid + 1], F16 = SF[16], M16 = SM[16], gi = G[(size_t)(ROW_M + tid) * 8 + h]; wv = __expf(F16 - Fs + gi - M16); }
            else wv = __expf((float)(15 - tid) * lg);
        }
        ((LAS float*)(lds + AOFF + ABUF))[384 + tid] = wv;
    }
    if (tid < 256) { const int dv = tid >> 2, s0 = (tid & 3) * 8;
        *(LAS u32x4*)(lds + VOFF + VBUF + pg8::lds_byte(dv, s0)) = *(const u32x4*)(VTb + (size_t)dv * MROWS + ROW_M + s0); }
    MIX_LOADKT(1, ROW_M);
    MIX_DMA(0);
    MIX_ARRAYS(0);
    __syncthreads();
    MIX_PACKKT(1, (LAS float*)(lds + AOFF + ABUF) + 384);
    MIX_STEPC(1, lds + VOFF + VBUF, 0.f);
    bf16x8 qa[8];
    { const bf16* qp = Q + (size_t)(b * 2048 + 16 * tb + fr) * 1024 + h * 256 + 8 * fq;
#pragma unroll
        for (int ks = 0; ks < 8; ++ks) qa[ks] = *(const bf16x8*)(qp + 32 * ks); }
    __syncthreads();
    MIX_WRITE_CBF();

    for (int c = 0; c < 16; ++c) {
        const int r0 = b * 2048 + 128 * c;
        const LAS unsigned char* vb = lds + VOFF + (c & 1) * VBUF;
        const LAS float* rowa = (const LAS float*)(lds + AOFF + (c & 1) * ABUF); const LAS float* colb = rowa + 128; const LAS float* wint = rowa + 256; const LAS float* wsv = rowa + 384; const LAS float* flo = rowa + 512;
        float wc;
        if (ML) { const int t0 = 16 + 128 * c; wc = __expf(SF[t0 + 128] - SF[t0] + SM[t0] - SM[t0 + 128]); } else wc = __expf(128.f * lg);
        const int tl = 16 * tb + fr, tq = tl - 4 * fq; const float ra = rowa[tl];
        bf16x8 sp[4];
#pragma unroll
        for (int hs = 0; hs < 2; ++hs) {
            if (hs == 0 || tb >= 4) {
                f32x4 S[4];
#pragma unroll
                for (int nb = 0; nb < 4; ++nb) S[nb] = (f32x4){0.f, 0.f, 0.f, 0.f};
#pragma unroll
                for (int ks = 0; ks < 8; ++ks)
#pragma unroll
                    for (int nb = 0; nb < 4; ++nb) {
                        const bf16x8 kf = *(const LAS bf16x8*)(lds + KOFF + (ks >> 1) * 16384 + (2 * (4 * hs + nb) + (ks & 1)) * 1024 + boff);
                        S[nb] = mfma16(kf, qa[ks], S[nb]);
                    }
#pragma unroll
                for (int k2 = 0; k2 < 2; ++k2) {
                    u32x4 p;
#pragma unroll
                    for (int hf = 0; hf < 2; ++hf) {
                        const int nbl = 2 * k2 + hf, nb = 4 * hs + nbl; const f32x4 cb = *(const LAS f32x4*)(colb + 16 * nb + 4 * fq); float r[4];
#pragma unroll
                        for (int e = 0; e < 4; ++e) { const float d = __expf(ra + cb[e]); r[e] = ((16 * nb + e) <= tq) ? S[nbl][e] * d : 0.f; }
                        if (hf == 0) { p.x = pk2(r[0], r[1]); p.y = pk2(r[2], r[3]); } else { p.z = pk2(r[0], r[1]); p.w = pk2(r[2], r[3]); }
                    }
                    sp[2 * hs + k2] = __builtin_bit_cast(bf16x8, p);
                }
            } else { sp[2] = (bf16x8){0, 0, 0, 0, 0, 0, 0, 0}; sp[3] = (bf16x8){0, 0, 0, 0, 0, 0, 0, 0}; }
            __builtin_amdgcn_sched_barrier(0);
        }
        asm volatile("s_waitcnt lgkmcnt(0)" ::: "memory"); __builtin_amdgcn_s_barrier(); asm volatile("" ::: "memory");
        const int cn = c < 15 ? c + 1 : 15;
        MIX_DMA_TO(cn, (c + 1) & 1);
        MIX_LOADKT(4, r0);
        __builtin_amdgcn_sched_barrier(0);
        const float wi = wint[tl];
        float scale = 1.f;
        bf16* hp = Hout + (size_t)(r0 + tl) * 1024 + h * 256 + slice * 64 + 4 * fq;
#pragma unroll
        for (int dbi = 0; dbi < NDB; ++dbi) {
            const int db = ML ? (dbi == 0 ? 4 : dbi - 1) : dbi;
            f32x4 o = (f32x4){0.f, 0.f, 0.f, 0.f};
#pragma unroll
            for (int ks = 0; ks < 8; ++ks) {
                const bf16x8 cf = *(const LAS bf16x8*)(lds + COFF + (ks >> 1) * 10240 + (2 * db + (ks & 1)) * 1024 + boff);
                o = mfma16(cf, qa[ks], o);
            }
            o = o * wi;
#pragma unroll
            for (int k2 = 0; k2 < 2; ++k2) {
                const LAS unsigned char* vp = vb + (2 * db + (k2 & 1)) * 1024;
                u32x4 q; { const u32x2 lo = *(const LAS u32x2*)(vp + vof0), hi = *(const LAS u32x2*)(vp + vof1); q.x = lo.x; q.y = lo.y; q.z = hi.x; q.w = hi.y; }
                o = mfma16(__builtin_bit_cast(bf16x8, q), sp[k2], o);
            }
            if (tb >= 4) {
#pragma unroll
                for (int k2 = 2; k2 < 4; ++k2) {
                    const LAS unsigned char* vp = vb + 10240 + (2 * db + (k2 & 1)) * 1024;
                    u32x4 q; { const u32x2 lo = *(const LAS u32x2*)(vp + vof0), hi = *(const LAS u32x2*)(vp + vof1); q.x = lo.x; q.y = lo.y; q.z = hi.x; q.w = hi.y; }
                    o = mfma16(__builtin_bit_cast(bf16x8, q), sp[k2], o);
                }
            }
            if (ML && dbi == 0) { const float den = __shfl(o[0], fr); scale = 1.f / fmaxf(fabsf(den), flo[tl]); }
            else { u32x2 ov; ov.x = pk2(o[0] * scale, o[1] * scale); ov.y = pk2(o[2] * scale, o[3] * scale); *(u32x2*)(hp + 16 * db) = ov; }
            __builtin_amdgcn_sched_barrier(0);
        }
        MIX_PACKKT(4, wsv);
        __builtin_amdgcn_sched_barrier(0);
        {
            const bf16* qp = Q + (size_t)(b * 2048 + 128 * cn + 16 * tb + fr) * 1024 + h * 256 + 8 * fq;
#pragma unroll
            for (int ks = 0; ks < 8; ++ks) qa[ks] = *(const bf16x8*)(qp + 32 * ks);
            MIX_ARRAYS_TO(cn, (c + 1) & 1);
        }
        __builtin_amdgcn_sched_barrier(0);
        MIX_STEPC(4, vb, wc);
        asm volatile("s_waitcnt vmcnt(0)" ::: "memory");
        __syncthreads();
        MIX_WRITE_CBF();
    }
    float* oC = a.out + (ML ? O_PC : O_PS) + (size_t)bh * 65536;
#pragma unroll
    for (int xb = 0; xb < 2; ++xb)
#pragma unroll
        for (int yb = 0; yb < 4; ++yb)
#pragma unroll
            for (int e = 0; e < 4; ++e) oC[(size_t)(32 * w + 16 * xb + 4 * fq + e) * 256 + slice * 64 + 16 * yb + fr] = Cacc[xb][yb][e];
    if (ML && slice == 0) {
        if (fr == 0) {
#pragma unroll
            for (int xb = 0; xb < 2; ++xb)
#pragma unroll
                for (int e = 0; e < 4; ++e) a.out[O_PN + (size_t)bh * 256 + 32 * w + 16 * xb + 4 * fq + e] = Cacc[xb][NDB - 1][e];
        }
        if (tid == 0) a.out[O_PM + bh] = SM[2064];
    }
    __syncthreads();
#undef MIX_STEPC
#undef MIX_WRITE_CBF
#undef MIX_LOADKT
#undef MIX_PACKKT
#undef MIX_DMA
#undef MIX_ARRAYS
#undef MIX_DMA_TO
#undef MIX_ARRAYS_TO
}

__device__ __forceinline__ void sample_unit(const Args& a, LAS unsigned char* lds, int branch, int n, int h) {
    int tid_ = threadIdx.x; asm volatile("" : "+v"(tid_));
    const int tid = tid_, w = __builtin_amdgcn_readfirstlane(tid >> 6), lane = tid & 63;
    unsigned char* ws = a.ws; const bool ML = branch == 0;
    const int row = ROW_S + n, nh = n * 4 + h;
    const bf16* Q = (const bf16*)(ws + WS_PROJ + (size_t)(ML ? 0 : 3) * SLOT);
    const bf16* Kr = (const bf16*)(ws + WS_PROJ + (size_t)(ML ? 1 : 4) * SLOT);
    const bf16* VT = (const bf16*)(ws + WS_PROJ + (size_t)(ML ? 9 : 11) * SLOT);
    bf16* Hout = (bf16*)(ws + (ML ? WS_HA : WS_HB));
    const float* G = (const float*)(ws + WS_G);
    const float* inC = (ML ? a.st_C : a.st_S) + (size_t)nh * 65536;
    float* outC = a.out + (ML ? O_SC : O_SS) + (size_t)nh * 65536;
    float ca, cb, mnew = 0.f;
    if (ML) { const float gi = G[(size_t)row * 8 + h], gf = logsigf_(G[(size_t)row * 8 + 4 + h]), m = a.st_m[nh]; mnew = fmaxf(gf + m, gi); ca = expf(gf + m - mnew); cb = expf(gi - mnew); }
    else { ca = 1.f - exp2f(-5.f - (float)h); cb = 1.f; }
    LAS float* sq = (LAS float*)lds; LAS float* sk = sq + 256; LAS float* sv = sq + 512; LAS float* red = sq + 768; LAS float* sden = red + 2048;
    if (tid < 256) { sq[tid] = bf2f(Q[(size_t)row * 1024 + h * 256 + tid]); sk[tid] = cb * bf2f(Kr[(size_t)row * 1024 + h * 256 + tid]); sv[tid] = bf2f(VT[(size_t)(h * 256 + tid) * MROWS + row]); }
    __syncthreads();
    const f32x4 v4 = ((const LAS f32x4*)sv)[lane];
    f32x4 acc = (f32x4){0.f, 0.f, 0.f, 0.f};
#pragma unroll 8
    for (int i = 0; i < 32; ++i) {
        const int r = w + 8 * i;
        const f32x4 c4 = ((const f32x4*)(inC + (size_t)r * 256))[lane];
        const f32x4 cn = c4 * ca + v4 * sk[r];
        ((f32x4*)(outC + (size_t)r * 256))[lane] = cn;
        acc += cn * sq[r];
    }
    ((LAS f32x4*)(red + w * 256))[lane] = acc;
    float dpart = 0.f;
    if (ML && tid < 256) { const float nn = ca * a.st_n[(size_t)nh * 256 + tid] + sk[tid]; a.out[O_SN + (size_t)nh * 256 + tid] = nn; dpart = sq[tid] * nn; }
    if (ML) { dpart = wave_sum(dpart); if (lane == 0) sden[w] = dpart; }
    __syncthreads();
    if (tid < 256) {
        float o = 0.f;
#pragma unroll
        for (int k = 0; k < 8; ++k) o += red[k * 256 + tid];
        if (ML) { const float den = sden[0] + sden[1] + sden[2] + sden[3]; o = o / fmaxf(fabsf(den), expf(-mnew)); }
        Hout[(size_t)row * 1024 + h * 256 + tid] = (bf16)f2bf(o);
    }
    if (ML && tid == 0) a.out[O_SM + nh] = mnew;
    __syncthreads();
}

__device__ __forceinline__ void p3_row_load(const bf16* HA, const bf16* HB, const bf16* MO, const bf16* RG, const bf16* GA, const bf16* GB, int row, int lane, u32x2 (&d)[4][6]) {
#pragma unroll
    for (int hh = 0; hh < 4; ++hh) { const size_t off = (size_t)row * 1024 + hh * 256;
        d[hh][0] = ((const u32x2*)(HA + off))[lane]; d[hh][1] = ((const u32x2*)(HB + off))[lane]; d[hh][2] = ((const u32x2*)(MO + off))[lane];
        d[hh][3] = ((const u32x2*)(RG + off))[lane]; d[hh][4] = ((const u32x2*)(GA + off))[lane]; d[hh][5] = ((const u32x2*)(GB + off))[lane]; }
}
__device__ __forceinline__ void p3_row_compute(const Args& a, bf16* MG, int row, int lane, const u32x2 (&d)[4][6]) {
#pragma unroll
    for (int hh = 0; hh < 4; ++hh) {
        const size_t off = (size_t)row * 1024 + hh * 256;
        const u32x2 ra = d[hh][0], rb = d[hh][1], go = d[hh][2], gg = d[hh][3], g1 = d[hh][4], g2 = d[hh][5];
        float xa[4] = {bf2f(ra.x & 0xffffu), bf2f(ra.x >> 16), bf2f(ra.y & 0xffffu), bf2f(ra.y >> 16)};
        float xb[4] = {bf2f(rb.x & 0xffffu), bf2f(rb.x >> 16), bf2f(rb.y & 0xffffu), bf2f(rb.y >> 16)};
        const float ma = wave_sum((xa[0] + xa[1]) + (xa[2] + xa[3])) * (1.f / 256.f), mb = wave_sum((xb[0] + xb[1]) + (xb[2] + xb[3])) * (1.f / 256.f);
        float qa = 0.f, qb = 0.f;
#pragma unroll
        for (int i = 0; i < 4; ++i) { xa[i] -= ma; xb[i] -= mb; qa += xa[i] * xa[i]; qb += xb[i] * xb[i]; }
        const float rsa = 1.f / sqrtf(wave_sum(qa) * (1.f / 256.f) + LN_EPS), rsb = 1.f / sqrtf(wave_sum(qb) * (1.f / 256.f) + LN_EPS);
        const f32x4 ga = ((const f32x4*)(a.ml_g + hh * 256))[lane], gb = ((const f32x4*)(a.rt_g + hh * 256))[lane];
        const float fo[4] = {bf2f(go.x & 0xffffu), bf2f(go.x >> 16), bf2f(go.y & 0xffffu), bf2f(go.y >> 16)};
        const float fg[4] = {bf2f(gg.x & 0xffffu), bf2f(gg.x >> 16), bf2f(gg.y & 0xffffu), bf2f(gg.y >> 16)};
        const float f1[4] = {bf2f(g1.x & 0xffffu), bf2f(g1.x >> 16), bf2f(g1.y & 0xffffu), bf2f(g1.y >> 16)};
        const float f2[4] = {bf2f(g2.x & 0xffffu), bf2f(g2.x >> 16), bf2f(g2.y & 0xffffu), bf2f(g2.y >> 16)};
        float r[4];
#pragma unroll
        for (int i = 0; i < 4; ++i) r[i] = f1[i] * (xa[i] * rsa * ga[i] * fo[i]) + f2[i] * (xb[i] * rsb * gb[i] * fg[i]);
        u32x2 o; o.x = pk2(r[0], r[1]); o.y = pk2(r[2], r[3]);
        ((u32x2*)(MG + off))[lane] = o;
    }
}
__device__ __forceinline__ void p3_merge(const Args& a) {
    const int tid = opaque_tid(), lane = tid & 63, wave = tid >> 6; const int gw = blockIdx.x * 8 + wave, NGW = gridDim.x * 8;
    unsigned char* ws = a.ws;
    const bf16* HA = (const bf16*)(ws + WS_HA); const bf16* HB = (const bf16*)(ws + WS_HB);
    const bf16* MO = (const bf16*)(ws + WS_PROJ + 2 * SLOT); const bf16* RG = (const bf16*)(ws + WS_PROJ + 5 * SLOT);
    const bf16* GA = (const bf16*)(ws + WS_PROJ + 6 * SLOT); const bf16* GB = (const bf16*)(ws + WS_PROJ + 7 * SLOT);
    bf16* MG = (bf16*)(ws + WS_XB);
    for (int row = ROW_V + gw; row < MROWS; row += NGW) {
#pragma unroll
        for (int hh = 0; hh < 4; ++hh) ((u32x2*)(MG + (size_t)row * 1024 + hh * 256))[lane] = (u32x2){0u, 0u};
    }
    for (int row = gw; row < ROW_V; row += 2 * NGW) {
        const int rowB = row + NGW; const bool hasB = rowB < ROW_V;
        u32x2 dA[4][6], dB[4][6];
        p3_row_load(HA, HB, MO, RG, GA, GB, row, lane, dA);
        p3_row_load(HA, HB, MO, RG, GA, GB, hasB ? rowB : row, lane, dB);
        p3_row_compute(a, MG, row, lane, dA);
        if (hasB) p3_row_compute(a, MG, rowB, lane, dB);
    }
}
template <bool FINAL>
__device__ __forceinline__ void ln_row_load(const float* src, const float* sbase, const float* part, int npart, int row, int lane, f32x4 (&v)[4]) {
    if (row < ROW_S) {
#pragma unroll
        for (int j = 0; j < 4; ++j) v[j] = ((const f32x4*)(src + (size_t)row * 1024))[lane + 64 * j];
    } else {
        const int r = row - ROW_S;
#pragma unroll
        for (int j = 0; j < 4; ++j) v[j] = ((const f32x4*)(sbase + (size_t)r * 1024))[lane + 64 * j] * ALPHA;
        for (int p = 0; p < npart; ++p)
#pragma unroll
            for (int j = 0; j < 4; ++j) v[j] += ((const f32x4*)(part + ((size_t)p * 128 + r) * 1024))[lane + 64 * j];
    }
}
template <bool FINAL>
__device__ __forceinline__ void ln_row_finish(const Args& a, int row, int lane, f32x4 (&v)[4], const f32x4 (&gv)[4], const f32x4 (&bv)[4]) {
    float* X1 = (float*)(a.ws + WS_X1); bf16* X1B = (bf16*)(a.ws + WS_X1B);
    float s = 0.f;
#pragma unroll
    for (int j = 0; j < 4; ++j) s += (v[j][0] + v[j][1]) + (v[j][2] + v[j][3]);
    const float mean = wave_sum(s) * (1.f / 1024.f); float q = 0.f;
#pragma unroll
    for (int j = 0; j < 4; ++j) { v[j] = v[j] - mean; q += (v[j][0] * v[j][0] + v[j][1] * v[j][1]) + (v[j][2] * v[j][2] + v[j][3] * v[j][3]); }
    const float rstd = 1.f / sqrtf(wave_sum(q) * (1.f / 1024.f) + LN_EPS);
#pragma unroll
    for (int j = 0; j < 4; ++j) {
        const f32x4 y = v[j] * rstd * gv[j] + bv[j];
        if (FINAL) { ((f32x4*)(a.out + (size_t)row * 1024))[lane + 64 * j] = y; }
        else { ((f32x4*)(X1 + (size_t)row * 1024))[lane + 64 * j] = y; u32x2 o; o.x = pk2(y[0], y[1]); o.y = pk2(y[2], y[3]); ((u32x2*)(X1B + (size_t)row * 1024))[lane + 64 * j] = o; }
    }
}
template <bool FINAL>
__device__ __forceinline__ void ln_phase(const Args& a, const float* src, const float* g, const float* bta, const float* sbase, const float* part, int npart) {
    const int tid = opaque_tid(), lane = tid & 63, wave = tid >> 6; const int gw = blockIdx.x * 8 + wave, NGW = gridDim.x * 8;
    bf16* X1B = (bf16*)(a.ws + WS_X1B);
    f32x4 gv[4], bv[4];
#pragma unroll
    for (int j = 0; j < 4; ++j) { gv[j] = ((const f32x4*)g)[lane + 64 * j]; bv[j] = ((const f32x4*)bta)[lane + 64 * j]; }
    if (!FINAL) for (int row = ROW_V + gw; row < MROWS; row += NGW) {
#pragma unroll
        for (int j = 0; j < 4; ++j) ((u32x2*)(X1B + (size_t)row * 1024))[lane + 64 * j] = (u32x2){0u, 0u};
    }
    for (int row = gw; row < ROW_V; row += 2 * NGW) {
        const int rowB = row + NGW; const bool hasB = rowB < ROW_V;
        f32x4 vA[4], vB[4];
        ln_row_load<FINAL>(src, sbase, part, npart, row, lane, vA);
        ln_row_load<FINAL>(src, sbase, part, npart, hasB ? rowB : row, lane, vB);
        ln_row_finish<FINAL>(a, row, lane, vA, gv, bv);
        if (hasB) ln_row_finish<FINAL>(a, rowB, lane, vB, gv, bv);
    }
}

#define XB_TMO      128
#define XB_XCNT(j)  (256  + 64 * (j))
#define XB_XSUB(j)  (1280 + 64 * (j))
#define XB_XGEN(j)  (2304 + 64 * (j))
#define XB_TOP      3328
#define XB_TOPGEN   3392
#define XCD_BAR_WORDS 3456
#define XB_SPIN_CAP (1u << 18)

__device__ __forceinline__ unsigned xb_ld(unsigned* p)              { return __hip_atomic_load(p, __ATOMIC_RELAXED, __HIP_MEMORY_SCOPE_AGENT); }
__device__ __forceinline__ unsigned xb_add(unsigned* p, unsigned v) { return __hip_atomic_fetch_add(p, v, __ATOMIC_RELAXED, __HIP_MEMORY_SCOPE_AGENT); }
__device__ __forceinline__ unsigned xb_xcc_id() { return (unsigned)__builtin_amdgcn_s_getreg((3 << 11) | 20) & 0xFu; }
#define XB_SPIN(cond, bar) do { unsigned _sp = 0; while (cond) { __builtin_amdgcn_s_sleep(1); \
    if ((++_sp & 255u) == 0u) { if (xb_ld(&(bar)[XB_TMO])) break; if (_sp > XB_SPIN_CAP) { atomicAdd(&(bar)[XB_TMO], 1u); break; } } } } while (0)

struct XcdBarrier {
    unsigned* bar; unsigned x;
    volatile LAS unsigned* st;
};

__device__ __forceinline__ XcdBarrier xcd_barrier_post(unsigned* bar, volatile LAS unsigned* st) {
    XcdBarrier b; b.bar = bar; b.x = xb_xcc_id(); b.st = st;
    if (threadIdx.x == 0) (void)xb_add(&bar[XB_XCNT(b.x)], 1u);
    return b;
}
__device__ __forceinline__ void xcd_barrier_complete(unsigned* bar, unsigned x, unsigned& nloc, unsigned& nx) {
    const unsigned G = gridDim.x * gridDim.y * gridDim.z;
    unsigned sum, cnt, mine, sp = 0u;
    for (;;) {
        sum = 0u; cnt = 0u; mine = 0u;
#pragma unroll
        for (unsigned j = 0; j < 16; ++j) { const unsigned c = xb_ld(&bar[XB_XCNT(j)]); sum += c; cnt += (c > 0u) ? 1u : 0u; mine = (j == x) ? c : mine; }
        if (sum == G) break;
        __builtin_amdgcn_s_sleep(1);
        if ((++sp & 255u) == 0u) { if (xb_ld(&bar[XB_TMO])) break; if (sp > XB_SPIN_CAP) { atomicAdd(&bar[XB_TMO], 1u); break; } }
    }
    nloc = mine > 0u ? mine : 1u; nx = cnt > 0u ? cnt : 1u;
}

__device__ __forceinline__ void xcd_barrier(const XcdBarrier& b) {
    asm volatile("s_waitcnt vmcnt(0)" ::: "memory");
    __syncthreads();
    if (threadIdx.x == 0) {
        unsigned* bar = b.bar;
        __builtin_amdgcn_s_waitcnt(0);
        unsigned nloc = b.st[0], nx = b.st[1];
        if (nloc == 0u) { xcd_barrier_complete(bar, b.x, nloc, nx); b.st[0] = nloc; b.st[1] = nx; }
        const unsigned old = xb_add(&bar[XB_XSUB(b.x)], 1u);
        const unsigned gen = old / nloc;
        if (old + 1u == (gen + 1u) * nloc) {
            __builtin_amdgcn_fence(__ATOMIC_RELEASE, "agent");
            asm volatile("s_waitcnt vmcnt(0)" ::: "memory");
            const unsigned og = xb_add(&bar[XB_TOP], 1u);
            const unsigned tg = og / nx;
            if (og + 1u == (tg + 1u) * nx) xb_add(&bar[XB_TOPGEN], 1u);
            else XB_SPIN(xb_ld(&bar[XB_TOPGEN]) == tg, bar);
            __builtin_amdgcn_fence(__ATOMIC_ACQUIRE, "agent");
            xb_add(&bar[XB_XGEN(b.x)], 1u);
            asm volatile("s_waitcnt vmcnt(0)" ::: "memory");
        } else {
            XB_SPIN(xb_ld(&bar[XB_XGEN(b.x)]) == gen, bar);
            __builtin_amdgcn_fence(__ATOMIC_ACQUIRE, "agent");
            asm volatile("s_waitcnt vmcnt(0)" ::: "memory");
        }
    }
    __syncthreads();
}


#ifndef REPEAT_SAMPLE
#define REPEAT_SAMPLE 1
#endif
#ifndef REPEAT_PROMPT
#define REPEAT_PROMPT 1
#endif
__global__ void __launch_bounds__(NTHR, 2) hybrid_fwd(Args a_) {
    extern __shared__ __attribute__((aligned(16))) unsigned char lds_raw[];
    LAS unsigned char* lds = (LAS unsigned char*)lds_raw;
    cg::grid_group grid = cg::this_grid();
    volatile LAS unsigned* bst = (volatile LAS unsigned*)(lds + LDS_BYTES - 64);
    if (threadIdx.x == 0) { bst[0] = 0u; bst[1] = 0u; }
    __syncthreads();
    const XcdBarrier xbar = xcd_barrier_post((unsigned*)(a_.ws + WS_CTL), bst);
#define GRID_SYNC(k) xcd_barrier(xbar)
    if (a_.ph_hi < a_.ph_lo) grid.sync();
    const int lo = a_.ph_lo, hi = a_.ph_hi;
#define FRESH_ARGS() auto kp_ = __builtin_amdgcn_kernarg_segment_ptr(); asm volatile("" : "+s"(kp_)); const Args& a = *(const Args*)kp_; unsigned char* ws = a.ws;
#ifdef DBG_STOP
#define PH_MASK ((2 << DBG_STOP) - 1)
#endif
#ifndef PH_MASK
#define PH_MASK 0x1ff
#endif
#define IN(k) (((PH_MASK >> (k)) & 1) && lo <= (k) && (k) < hi)
#ifndef REPEAT_MASK
#define REPEAT_MASK 0
#endif
#define PH_BEGIN(k) for (int r_ = 0; r_ < (((REPEAT_MASK >> (k)) & 1) ? 2 : 1); ++r_) { if (IN(k))
#define PH_END(k) if ((r_ == 0 && ((REPEAT_MASK >> (k)) & 1)) || (IN(k) && IN((k) + 1))) GRID_SYNC(k); }
    PH_BEGIN(0) { FRESH_ARGS() p0_prologue(a, lds); } PH_END(0)
    PH_BEGIN(1) { FRESH_ARGS()
        if (blockIdx.x < 32) { gate_scan(a, lds, blockIdx.x); __syncthreads(); }
        const pg8::Gemm g = mk_gemm((const bf16*)(ws + WS_XB), (const bf16*)(ws + WS_WIN), MROWS, 10240, 1024); pg8::StaticOrder S; S.init(MROWS, 10240, gridDim.x, blockIdx.x);
        EpiProj E{ws, a.b_in};
        pg8::gemm_phase<EpiProj, pg8::StaticOrder, true, true>(lds, g, S, E);
    }
    PH_END(1)
    PH_BEGIN(2) { FRESH_ARGS()
        for (int rp_ = 0; rp_ < REPEAT_PROMPT; ++rp_)
        for (int u = blockIdx.x; u < 256; u += gridDim.x) {
            const int combo = (u & 7) * 8 + ((u >> 3) & 7), slice = u >> 6;
            const int branch = combo >> 5, b = (combo >> 2) & 7, h = combo & 3;
            if (branch == 0) mixer_unit<true>(a, lds, b, h, slice); else mixer_unit<false>(a, lds, b, h, slice);
        }
        for (int rs_ = 0; rs_ < REPEAT_SAMPLE; ++rs_)
        for (int u = blockIdx.x; u < 1024; u += gridDim.x) sample_unit(a, lds, u >> 9, (u & 511) >> 2, u & 3);
    }
    PH_END(2)
    PH_BEGIN(3) { FRESH_ARGS() p3_merge(a); } PH_END(3)
    PH_BEGIN(4) { FRESH_ARGS()
        { const pg8::Gemm g = mk_gemm((const bf16*)(ws + WS_XB), (const bf16*)(ws + WS_WOUT), ROW_S, 1024, 1024); pg8::StaticOrder S; S.init(ROW_S, 1024, gridDim.x, blockIdx.x);
          EpiRes E{a.x_prompt, (float*)(ws + WS_PRE1)};
          pg8::gemm_phase<EpiRes, pg8::StaticOrder, true, true>(lds, g, S, E); }
        { const pg8::Gemm g = mk_gemm_splitk((const bf16*)(ws + WS_XB) + (size_t)ROW_S * 1024, (const bf16*)(ws + WS_WOUT), 4, 1024, 256, 1024); pg8::StaticOrder S; S.init(4 * 256, 1024, gridDim.x, blockIdx.x);
          EpiPart E{(float*)(ws + WS_PART4)};
          pg8::gemm_phase<EpiPart, pg8::StaticOrder, true, true>(lds, g, S, E); }
    }
    PH_END(4)
    PH_BEGIN(5) { FRESH_ARGS() ln_phase<false>(a, (const float*)(ws + WS_PRE1), a.ln1_g, a.ln1_b, a.x_sample, (const float*)(ws + WS_PART4), 4); } PH_END(5)
    PH_BEGIN(6) { FRESH_ARGS()
        const pg8::Gemm g = mk_gemm((const bf16*)(ws + WS_X1B), (const bf16*)(ws + WS_WGU), MROWS, 2 * DFF, 1024); pg8::StaticOrder S; S.init(MROWS, 2 * DFF, gridDim.x, blockIdx.x);
        EpiGU E{(bf16*)(ws + WS_HBUF)};
        pg8::gemm_phase<EpiGU, pg8::StaticOrder, true, true>(lds, g, S, E);
    }
    PH_END(6)
    PH_BEGIN(7) { FRESH_ARGS()
        { const pg8::Gemm g = mk_gemm((const bf16*)(ws + WS_HBUF), (const bf16*)(ws + WS_WDN), ROW_S, 1024, DFF); pg8::StaticOrder S; S.init(ROW_S, 1024, gridDim.x, blockIdx.x);
          EpiRes E{(const float*)(ws + WS_X1), (float*)(ws + WS_PRE2)};
          pg8::gemm_phase<EpiRes, pg8::StaticOrder, true, true>(lds, g, S, E); }
        { const pg8::Gemm g = mk_gemm_splitk((const bf16*)(ws + WS_HBUF) + (size_t)ROW_S * DFF, (const bf16*)(ws + WS_WDN), 11, 1024, 256, DFF); pg8::StaticOrder S; S.init(11 * 256, 1024, gridDim.x, blockIdx.x);
          EpiPart E{(float*)(ws + WS_PART7)};
          pg8::gemm_phase<EpiPart, pg8::StaticOrder, true, true>(lds, g, S, E); }
    }
    PH_END(7)
    PH_BEGIN(8) { FRESH_ARGS() ln_phase<true>(a, (const float*)(ws + WS_PRE2), a.ln2_g, a.ln2_b, (const float*)(ws + WS_X1) + (size_t)ROW_S * 1024, (const float*)(ws + WS_PART7), 11); } PH_END(8)
#ifdef EXTRA_SYNCS
    for (int i_ = 0; i_ < EXTRA_SYNCS; ++i_) GRID_SYNC(1);
#endif
#ifdef DBG_STOP
    if (lo <= 9 && 9 < hi) { FRESH_ARGS()
        if (lo == 0) grid.sync();
        const size_t gt = (size_t)blockIdx.x * NTHR + threadIdx.x, nt = (size_t)gridDim.x * NTHR;
#if DBG_STOP == 1
        const bf16* sy = (const bf16*)(ws + WS_PROJ); const bf16* sc = (const bf16*)(ws + WS_PROJ + 8 * SLOT); const bf16* ss = (const bf16*)(ws + WS_PROJ + 10 * SLOT);
        for (size_t i = gt; i < O_PC; i += nt) a.out[i] = bf2f(sy[i]);
        for (size_t i = gt; i < 33554432; i += nt) { a.out[O_SC + i] = bf2f(sc[i]); a.out[O_SS + i] = bf2f(ss[i]); }
        for (size_t i = O_PC + gt; i < O_SC; i += nt) a.out[i] = 0.f;
        for (size_t i = O_SN + gt; i < O_SS; i += nt) a.out[i] = 0.f;
#elif DBG_STOP == 2
        const bf16* sy = (const bf16*)(ws + WS_HA);
        for (size_t i = gt; i < O_PC; i += nt) a.out[i] = bf2f(sy[i]) + bf2f(sy[i + SLOT / 2]);
#elif DBG_STOP == 0
        const bf16* sy = (const bf16*)(ws + WS_XB); const bf16* sc = (const bf16*)(ws + WS_WIN);
        for (size_t i = gt; i < O_PC; i += nt) a.out[i] = bf2f(sy[i]);
        for (size_t i = gt; i < 33554432; i += nt) { a.out[O_SC + i] = i < 10485760 ? bf2f(sc[i]) : 0.f; a.out[O_SS + i] = i < 8 * MROWS ? ((const float*)(ws + WS_G))[i] : 0.f; }
        for (size_t i = O_PC + gt; i < O_SC; i += nt) a.out[i] = 0.f;
        for (size_t i = O_SN + gt; i < O_SS; i += nt) a.out[i] = 0.f;
#endif
    }
#endif
#undef IN
#undef PH_BEGIN
#undef PH_END
}

#ifndef N_LAUNCH_SPLIT
#define N_LAUNCH_SPLIT 0
#endif
extern "C" void kernel_launch(void* const* d_in, const int* in_sizes, int n_in, void* d_out, int out_size, void* d_ws, size_t ws_size, hipStream_t stream) {
    static int grid = 0;
    if (grid == 0) {
        if (n_in != 19 || ws_size < WS_END) { fprintf(stderr, "kernel_launch: need 19 inputs and %zu bytes of workspace; got %d, %zu\n", (size_t)WS_END, n_in, ws_size); grid = -1; return; }
        int dev = 0, cus = 0, per_cu = 0;
        if (hipGetDevice(&dev) != hipSuccess || hipDeviceGetAttribute(&cus, hipDeviceAttributeMultiprocessorCount, dev) != hipSuccess) { grid = -1; return; }
        if (hipFuncSetAttribute((const void*)hybrid_fwd, hipFuncAttributeMaxDynamicSharedMemorySize, LDS_BYTES) != hipSuccess) { fprintf(stderr, "kernel_launch: hipFuncSetAttribute failed\n"); grid = -1; return; }
        if (hipOccupancyMaxActiveBlocksPerMultiprocessor(&per_cu, (const void*)hybrid_fwd, NTHR, LDS_BYTES) != hipSuccess || per_cu < 1) { fprintf(stderr, "kernel_launch: occupancy query says %d blocks per CU\n", per_cu); grid = -1; return; }
        grid = cus;
    }
    if (grid < 0) return;
    Args a{};
    a.x_prompt = (const float*)d_in[0]; a.x_sample = (const float*)d_in[1]; a.st_C = (const float*)d_in[2]; a.st_n = (const float*)d_in[3]; a.st_m = (const float*)d_in[4]; a.st_S = (const float*)d_in[5];
    a.meta = (const float*)d_in[6]; a.w_in = (const float*)d_in[7]; a.b_in = (const float*)d_in[8]; a.ml_g = (const float*)d_in[9]; a.rt_g = (const float*)d_in[10]; a.w_out = (const float*)d_in[11];
    a.ln1_g = (const float*)d_in[12]; a.ln1_b = (const float*)d_in[13]; a.w_gate = (const float*)d_in[14]; a.w_up = (const float*)d_in[15]; a.w_down = (const float*)d_in[16]; a.ln2_g = (const float*)d_in[17]; a.ln2_b = (const float*)d_in[18];
    a.out = (float*)d_out; a.ws = (unsigned char*)d_ws;
    if (hipMemsetAsync((char*)d_ws + WS_CTL, 0, CTL_BYTES, stream) != hipSuccess) { fprintf(stderr, "kernel_launch: memset of the barrier words failed\n"); return; }
#if N_LAUNCH_SPLIT
    for (int p = 0; p < 10; ++p) { a.ph_lo = p; a.ph_hi = p + 1; hipLaunchKernelGGL(hybrid_fwd, dim3(grid), dim3(NTHR), LDS_BYTES, stream, a); }
#else
    a.ph_lo = 0; a.ph_hi = 10;
    void* args[] = {&a};
    hipError_t e = hipLaunchCooperativeKernel((const void*)hybrid_fwd, dim3(grid), dim3(NTHR), args, LDS_BYTES, stream);
    if (e != hipSuccess) fprintf(stderr, "kernel_launch: cooperative launch failed: %s (grid %d)\n", hipGetErrorString(e), grid);
#endif
}
```
